# Optimizing an MI355X kernel written in HIP

```python
import jax
import jax.numpy as jnp
from jax import lax
import numpy as np

D_MODEL = 1024
BATCH = 4
SEQ = 4096
DEPTH = 1

MEM_LEN = 256
SSM_GROUP = 16
SSM_WIDTH = 768
SSM_GROUPS = SSM_WIDTH // SSM_GROUP
SSM_STATE = 64
SSM_DT_MIN = 0.001
SSM_DT_MAX = 0.1
ATT_HEAD_DIM = 64
ATT_HEADS_PER_GROUP = 4
DILATION_PATTERN = ((128, 1), (512, 4), (2048, 16))
ATT_GROUPS = len(DILATION_PATTERN)
ATT_HEADS = ATT_GROUPS * ATT_HEADS_PER_GROUP
ATT_WIDTH = ATT_HEADS * ATT_HEAD_DIM
ATT_MERGED = ATT_HEADS_PER_GROUP * ATT_HEAD_DIM
ATT_SCALE = ATT_HEAD_DIM ** -0.5
ROT_DIM = ATT_HEAD_DIM // 4
ROPE_THETA = 500000.0
XATT_HEADS = 4
XATT_HEAD_DIM = D_MODEL // XATT_HEADS
XATT_SCALE = XATT_HEAD_DIM ** -0.5
D_FF = 4 * D_MODEL
DEEPNORM_ALPHA = (2 * DEPTH) ** 0.25
DEEPNORM_BETA = (8 * DEPTH) ** -0.25
LN_EPS = 1e-5
NEG_INF = -1e30
OFF_U = 0
OFF_Q = OFF_U + SSM_WIDTH
OFF_K = OFF_Q + ATT_WIDTH
OFF_V = OFF_K + ATT_WIDTH
OFF_GS = OFF_V + ATT_WIDTH
OFF_GA = OFF_GS + D_MODEL
IN_COLS = OFF_GA + D_MODEL

kernel_name = 'hybrid_s5_dilated_attn_block'


def layer_norm(x, g, b):
    xf = x.astype(jnp.float32)
    mu = jnp.mean(xf, axis=-1, keepdims=True)
    var = jnp.mean(jnp.square(xf - mu), axis=-1, keepdims=True)
    y = (xf - mu) * lax.rsqrt(var + LN_EPS) * g.astype(jnp.float32) + b.astype(jnp.float32)
    return y.astype(x.dtype)


def rope_partial(t, cos, sin):
    half = ROT_DIM // 2
    rot = t[..., :ROT_DIM].astype(jnp.float32)
    x1, x2 = rot[..., :half], rot[..., half:]
    c = cos[:, :, None, :]
    s = sin[:, :, None, :]
    rot = jnp.concatenate([x1 * c - x2 * s, x2 * c + x1 * s], axis=-1).astype(t.dtype)
    return jnp.concatenate([rot, t[..., ROT_DIM:]], axis=-1)


def s5_ssm(u, log_dt, a_re, a_im, b_re, b_im, c_re, c_im, d):
    f32 = jnp.float32
    bsz, s, _ = u.shape
    uf = u.astype(f32)
    ug = uf.reshape(bsz, s, SSM_GROUPS, SSM_GROUP)
    a_re = a_re.astype(f32)
    a_im = a_im.astype(f32)
    dt = jnp.exp(log_dt.astype(f32))[:, None]
    mag = jnp.exp(a_re * dt)
    ab_re = mag * jnp.cos(a_im * dt)
    ab_im = mag * jnp.sin(a_im * dt)
    den = jnp.square(a_re) + jnp.square(a_im)
    nr = ab_re - 1.0
    f_re = (nr * a_re + ab_im * a_im) / den
    f_im = (ab_im * a_re - nr * a_im) / den
    b_re = b_re.astype(f32)
    b_im = b_im.astype(f32)
    bb_re = f_re[..., None] * b_re - f_im[..., None] * b_im
    bb_im = f_re[..., None] * b_im + f_im[..., None] * b_re
    w_re = jnp.einsum('bsgc,gnc->bsgn', ug, bb_re)
    w_im = jnp.einsum('bsgc,gnc->bsgn', ug, bb_im)
    ar = jnp.broadcast_to(ab_re, w_re.shape)
    ai = jnp.broadcast_to(ab_im, w_im.shape)

    def combine(e1, e2):
        a1r, a1i, b1r, b1i = e1
        a2r, a2i, b2r, b2i = e2
        return (a2r * a1r - a2i * a1i,
                a2r * a1i + a2i * a1r,
                a2r * b1r - a2i * b1i + b2r,
                a2r * b1i + a2i * b1r + b2i)

    _, _, h_re, h_im = lax.associative_scan(combine, (ar, ai, w_re, w_im), axis=1)
    y = (jnp.einsum('bsgn,gcn->bsgc', h_re, c_re.astype(f32))
         - jnp.einsum('bsgn,gcn->bsgc', h_im, c_im.astype(f32)))
    y = y.reshape(bsz, s, SSM_WIDTH) + d.astype(f32) * uf
    return y.astype(u.dtype)


def dilated_window_attention(q, k, v, window, dilation):
    bsz, s, h, dh = q.shape
    span = window // dilation
    blk = span
    unit = blk * dilation
    length = -(-s // unit) * unit
    n_blk = length // unit
    pad = length - s

    def arrange(t):
        t = jnp.pad(t, ((0, 0), (0, pad), (0, 0), (0, 0)))
        t = t.reshape(bsz, length // dilation, dilation, h, dh)
        t = t.transpose(0, 2, 1, 3, 4)
        return t.reshape(bsz, dilation, n_blk, blk, h, dh)

    def with_prev(t):
        prev = jnp.pad(t, ((0, 0), (0, 0), (1, 0), (0, 0), (0, 0), (0, 0)))[:, :, :-1]
        return jnp.concatenate([prev, t], axis=3)

    qb = arrange(q)
    kw = with_prev(arrange(k))
    vw = with_prev(arrange(v))
    scores = jnp.einsum('brnqhd,brnkhd->brnhqk', qb, kw).astype(jnp.float32) * ATT_SCALE
    qi = jnp.arange(blk)[:, None]
    ki = jnp.arange(2 * blk)[None, :]
    steps = qi + blk - ki
    band = (steps >= 0) & (steps <= span)
    has_prev = (jnp.arange(n_blk) > 0)[:, None, None]
    valid = band[None] & (has_prev | (ki >= blk)[None])
    scores = jnp.where(valid[None, None, :, None], scores, NEG_INF)
    m = jnp.max(scores, axis=-1, keepdims=True)
    p = jnp.exp(scores - m)
    den = jnp.sum(p, axis=-1, keepdims=True)
    lse = (m + jnp.log(den))[..., 0]
    out = jnp.einsum('brnhqk,brnkhd->brnhqd', p, vw.astype(jnp.float32)) / den
    out = out.transpose(0, 1, 2, 4, 3, 5).reshape(bsz, dilation, length // dilation, h, dh)
    out = out.transpose(0, 2, 1, 3, 4).reshape(bsz, length, h, dh)[:, :s]
    lse = lse.transpose(0, 1, 2, 4, 3).reshape(bsz, dilation, length // dilation, h)
    lse = lse.transpose(0, 2, 1, 3).reshape(bsz, length, h)[:, :s]
    return out, lse


def memory_cross_attention(h, mem, w_xq, w_xkv, w_xo):
    bsz, s, _ = h.shape
    q = (h @ w_xq).reshape(bsz, s, XATT_HEADS, XATT_HEAD_DIM)
    kv = mem @ w_xkv
    k = kv[..., :D_MODEL].reshape(bsz, -1, XATT_HEADS, XATT_HEAD_DIM)
    v = kv[..., D_MODEL:].reshape(bsz, -1, XATT_HEADS, XATT_HEAD_DIM)
    scores = jnp.einsum('bshd,bmhd->bhsm', q, k).astype(jnp.float32) * XATT_SCALE
    p = jax.nn.softmax(scores, axis=-1)
    o = jnp.einsum('bhsm,bmhd->bshd', p, v.astype(jnp.float32)).astype(h.dtype)
    return o.reshape(bsz, s, D_MODEL) @ w_xo


def setup_inputs(seed: int = 0) -> dict:
    key = jax.random.key(seed)
    ks = jax.random.split(key, 40)
    f32 = jnp.float32
    L, D, G, N, C = DEPTH, D_MODEL, SSM_GROUPS, SSM_STATE, SSM_GROUP

    def nrm(k, shape, scale):
        return jax.random.normal(k, shape, f32) * scale

    def gain(k, shape):
        return 1.0 + nrm(k, shape, 0.05)

    n_idx = jnp.arange(N, dtype=f32)
    inp = {
        'x': nrm(ks[0], (BATCH, SEQ, D), 1.0),
        'mem': nrm(ks[1], (BATCH, MEM_LEN, D), 1.0),
        'positions': jnp.broadcast_to(jnp.arange(SEQ, dtype=jnp.int32)[None, :], (BATCH, SEQ)),
        'ln_in_g': gain(ks[2], (D,)),
        'ln_in_b': nrm(ks[3], (D,), 0.02),
        'w_in': nrm(ks[4], (L, D, IN_COLS), D ** -0.5),
        'b_in': nrm(ks[5], (L, IN_COLS), 0.02),
        'ssm_log_dt': jax.random.uniform(ks[6], (L, G), f32, np.log(SSM_DT_MIN), np.log(SSM_DT_MAX)),
        'ssm_a_re': -0.5 + nrm(ks[7], (L, G, N), 0.01),
        'ssm_a_im': jnp.pi * n_idx + nrm(ks[8], (L, G, N), 0.01),
        'ssm_b_re': nrm(ks[9], (L, G, N, C), (0.5 / C) ** 0.5),
        'ssm_b_im': nrm(ks[10], (L, G, N, C), (0.5 / C) ** 0.5),
        'ssm_c_re': nrm(ks[11], (L, G, C, N), (0.5 / N) ** 0.5),
        'ssm_c_im': nrm(ks[12], (L, G, C, N), (0.5 / N) ** 0.5),
        'ssm_d': nrm(ks[13], (L, SSM_WIDTH), 1.0),
        'w_glu': nrm(ks[14], (L, SSM_WIDTH, 2 * D), SSM_WIDTH ** -0.5),
        'b_glu': nrm(ks[15], (L, 2 * D), 0.02),
        'w_att_up': nrm(ks[16], (L, ATT_MERGED, D), ATT_MERGED ** -0.5),
        'w_mix_out': nrm(ks[17], (L, D, D), DEEPNORM_BETA * D ** -0.5),
        'b_mix_out': nrm(ks[18], (L, D), 0.02),
        'ln1_g': gain(ks[19], (L, D)),
        'ln1_b': nrm(ks[20], (L, D), 0.02),
        'w_xq': nrm(ks[21], (L, D, D), D ** -0.5),
        'w_xkv': nrm(ks[22], (L, D, 2 * D), D ** -0.5),
        'w_xo': nrm(ks[23], (L, D, D), DEEPNORM_BETA * D ** -0.5),
        'ln2_g': gain(ks[24], (L, D)),
        'ln2_b': nrm(ks[25], (L, D), 0.02),
        'w_ff1': nrm(ks[26], (L, D, D_FF), D ** -0.5),
        'b_ff1': nrm(ks[27], (L, D_FF), 0.02),
        'w_ff2': nrm(ks[28], (L, D_FF, D), DEEPNORM_BETA * D_FF ** -0.5),
        'b_ff2': nrm(ks[29], (L, D), 0.02),
        'ln3_g': gain(ks[30], (L, D)),
        'ln3_b': nrm(ks[31], (L, D), 0.02),
    }
    return inp


def reference(x, mem, positions, ln_in_g, ln_in_b, w_in, b_in, ssm_log_dt, ssm_a_re, ssm_a_im,
              ssm_b_re, ssm_b_im, ssm_c_re, ssm_c_im, ssm_d, w_glu, b_glu, w_att_up, w_mix_out,
              b_mix_out, ln1_g, ln1_b, w_xq, w_xkv, w_xo, ln2_g, ln2_b, w_ff1, b_ff1, w_ff2, b_ff2,
              ln3_g, ln3_b):
    bsz, s, _ = x.shape
    inv_freq = ROPE_THETA ** (-jnp.arange(0, ROT_DIM, 2, dtype=jnp.float32) / ROT_DIM)
    ang = positions.astype(jnp.float32)[..., None] * inv_freq
    cos, sin = jnp.cos(ang), jnp.sin(ang)

    h = layer_norm(x, ln_in_g, ln_in_b)
    for l in range(DEPTH):
        proj = h @ w_in[l] + b_in[l]
        u = proj[..., OFF_U:OFF_U + SSM_WIDTH]
        q = proj[..., OFF_Q:OFF_Q + ATT_WIDTH].reshape(bsz, s, ATT_HEADS, ATT_HEAD_DIM)
        k = proj[..., OFF_K:OFF_K + ATT_WIDTH].reshape(bsz, s, ATT_HEADS, ATT_HEAD_DIM)
        v = proj[..., OFF_V:OFF_V + ATT_WIDTH].reshape(bsz, s, ATT_HEADS, ATT_HEAD_DIM)
        g_ssm = proj[..., OFF_GS:OFF_GS + D_MODEL]
        g_att = proj[..., OFF_GA:OFF_GA + D_MODEL]

        y = s5_ssm(u, ssm_log_dt[l], ssm_a_re[l], ssm_a_im[l], ssm_b_re[l], ssm_b_im[l],
                   ssm_c_re[l], ssm_c_im[l], ssm_d[l])
        z = jax.nn.gelu(y) @ w_glu[l] + b_glu[l]
        b_ssm = z[..., :D_MODEL] * jax.nn.sigmoid(z[..., D_MODEL:])

        q = rope_partial(q, cos, sin)
        k = rope_partial(k, cos, sin)
        outs, lses = [], []
        for gi, (win, dil) in enumerate(DILATION_PATTERN):
            sl = slice(gi * ATT_HEADS_PER_GROUP, (gi + 1) * ATT_HEADS_PER_GROUP)
            o_g, lse_g = dilated_window_attention(q[:, :, sl], k[:, :, sl], v[:, :, sl], win, dil)
            outs.append(o_g)
            lses.append(lse_g)
        wts = jax.nn.softmax(jnp.stack(lses, axis=0), axis=0)
        att = jnp.einsum('gbsh,gbshd->bshd', wts, jnp.stack(outs, axis=0)).astype(h.dtype)
        b_att = att.reshape(bsz, s, ATT_MERGED) @ w_att_up[l]

        mixed = jax.nn.sigmoid(g_ssm) * b_ssm + jax.nn.sigmoid(g_att) * b_att
        h = layer_norm(DEEPNORM_ALPHA * h + (mixed @ w_mix_out[l] + b_mix_out[l]), ln1_g[l], ln1_b[l])

        xo = memory_cross_attention(h, mem, w_xq[l], w_xkv[l], w_xo[l])
        h = layer_norm(DEEPNORM_ALPHA * h + xo, ln2_g[l], ln2_b[l])

        ff = jnp.square(jax.nn.relu(h @ w_ff1[l] + b_ff1[l])) @ w_ff2[l] + b_ff2[l]
        h = layer_norm(DEEPNORM_ALPHA * h + ff, ln3_g[l], ln3_b[l])
    return h
```

```cpp
#include <hip/hip_runtime.h>
#include <hip/hip_cooperative_groups.h>
#include <cstdio>
#include <cstdint>
namespace cg = cooperative_groups;
namespace pg8 {
#define PG8_LAS __attribute__((address_space(3)))
typedef unsigned short bf16_t;
typedef short bf16x8 __attribute__((ext_vector_type(8)));
typedef float f32x4 __attribute__((ext_vector_type(4)));
typedef unsigned u32x4 __attribute__((ext_vector_type(4)));
constexpr int BM = 256, BK = 64, HALF = 128, HTB = HALF * BK * 2  , STAGE_BYTES = 8 * HTB, NXCD = 8, WGM = 8;

__host__ __device__ __forceinline__ int lds_byte(int r, int c) { const int st = (r >> 4) * 2 + (c >> 5), rr = r & 15, cc = c & 31, ob = rr * 64 + cc * 2; return st * 1024 + (ob ^ (((ob >> 9) & 1) << 5)); }
__host__ __device__ __forceinline__ void stage_rc(int b, int& R, int& C) { const int st = b / 1024, sb = b % 1024, swz = sb ^ (((sb >> 9) & 1) << 5); R = (st >> 1) * 16 + swz / 64; C = (st & 1) * 32 + (swz % 64) / 2; }
__host__ __device__ __forceinline__ int perm32(int rho) { const int n = rho >> 4, i = rho & 15; return 8 * (i >> 2) + 4 * n + (i & 3); }

struct Unit { int pm, pn; };
struct Gemm { const bf16_t* A; const bf16_t* Bt; int M, N, K; };

struct StaticOrder {
    int nM, nN, nwg, G, c;
    __host__ __device__ void init(int M, int N, int G_, int c_) { nM = M / BM; nN = N / BM; nwg = nM * nN; G = G_; c = c_; }
    __host__ __device__ bool next(int i, Unit& u) const {
        const long L = (long)i * G + c; if (L >= nwg) return false;
        int wgid = (int)L; { const int q = nwg / NXCD, r = nwg % NXCD, xcd = wgid % NXCD, off = wgid / NXCD; wgid = (xcd < r ? xcd * (q + 1) : r * (q + 1) + (xcd - r) * q) + off; }
        const int nig = WGM * nN, gid = wgid / nig, fm = gid * WGM, gsz = (nM - fm) < WGM ? (nM - fm) : WGM;
        u.pm = fm + ((wgid % nig) % gsz); u.pn = (wgid % nig) / gsz; return true;
    }
    __device__ __forceinline__ void a_ready(const Unit&) const {}
    __device__ __forceinline__ void done(const Unit&) const {}
};

__device__ __forceinline__ unsigned cvt_pk_bf16(float lo, float hi) { unsigned r; asm volatile("v_cvt_pk_bf16_f32 %0, %1, %2" : "=v"(r) : "v"(lo), "v"(hi)); return r; }
typedef float f32x2 __attribute__((ext_vector_type(2)));
__device__ __forceinline__ float bf2f(unsigned short h) { return __uint_as_float(((unsigned)h) << 16); }
__device__ __forceinline__ float sigmoidf_(float x) { return __builtin_amdgcn_rcpf(1.0f + __builtin_amdgcn_exp2f(-1.4426950408889634f * x)); }
__device__ __forceinline__ u32x4 pack8(const f32x4 v0, const f32x4 v1) { u32x4 w; w.x = cvt_pk_bf16(v0[0], v0[1]); w.y = cvt_pk_bf16(v0[2], v0[3]); w.z = cvt_pk_bf16(v1[0], v1[1]); w.w = cvt_pk_bf16(v1[2], v1[3]); return w; }
__device__ __forceinline__ void unpack8(const u32x4 w, f32x4& v0, f32x4& v1) {
    v0[0] = __uint_as_float(w.x << 16); v0[1] = __uint_as_float(w.x & 0xffff0000u); v0[2] = __uint_as_float(w.y << 16); v0[3] = __uint_as_float(w.y & 0xffff0000u);
    v1[0] = __uint_as_float(w.z << 16); v1[1] = __uint_as_float(w.z & 0xffff0000u); v1[2] = __uint_as_float(w.w << 16); v1[3] = __uint_as_float(w.w & 0xffff0000u); }

template <int ACT> struct EpiPlain {
    static constexpr bool PERM = true, AFTER_DRAIN = false;
    bf16_t* O; int ldc; const float* bias; float scale;
    __device__ __forceinline__ void operator()(const f32x4 (&acc)[2][2][4][2], const Unit& u, int wr, int wc, int fr, int fq) const {
        const int row0 = u.pm * BM + wr * 64 + fr, col0 = u.pn * BM + wc * 32 + 8 * fq;
#pragma unroll
        for (int bj = 0; bj < 2; ++bj) {
            f32x4 b0 = (f32x4){0.f, 0.f, 0.f, 0.f}, b1 = b0;
            if (bias) { b0 = *(const f32x4*)(bias + col0 + bj * HALF); b1 = *(const f32x4*)(bias + col0 + bj * HALF + 4); }
#pragma unroll
            for (int ai = 0; ai < 2; ++ai)
#pragma unroll
                for (int m = 0; m < 4; ++m) {
                    f32x4 v0 = acc[ai][bj][m][0] + b0, v1 = acc[ai][bj][m][1] + b1;
                    if (ACT == 2) {
#pragma unroll
                        for (int e = 0; e < 4; ++e) { float a = fmaxf(v0[e], 0.f); v0[e] = a * a; float c = fmaxf(v1[e], 0.f); v1[e] = c * c; } }
                    v0 = v0 * scale; v1 = v1 * scale;
                    *(u32x4*)(O + (size_t)(row0 + ai * HALF + m * 16) * ldc + col0 + bj * HALF) = pack8(v0, v1);
                }
        }
    }
};

struct EpiProj {
    static constexpr bool PERM = true, AFTER_DRAIN = false;
    bf16_t *U, *Q, *K, *V, *GS, *GA; const float* bias; const float* rope;
    __device__ __forceinline__ void operator()(const f32x4 (&acc)[2][2][4][2], const Unit& u, int wr, int wc, int fr, int fq) const {
        const int row0 = u.pm * BM + wr * 64 + fr, colg = u.pn * BM + wc * 32 + 8 * fq;
        bf16_t* base; int ldc, coll; bool rot = false;
        const int pn = u.pn;
        if (pn < 3) { base = U; ldc = 768; coll = colg; }
        else if (pn < 6) { base = Q; ldc = 768; coll = colg - 768; rot = true; }
        else if (pn < 9) { base = K; ldc = 768; coll = colg - 1536; rot = true; }
        else if (pn < 12) { base = V; ldc = 768; coll = colg - 2304; }
        else if (pn < 16) { base = GS; ldc = 1024; coll = colg - 3072; }
        else { base = GA; ldc = 1024; coll = colg - 4096; }
        const bool rl = rot && ((wc & 1) == 0);
#pragma unroll
        for (int bj = 0; bj < 2; ++bj) {
            const f32x4 b0 = *(const f32x4*)(bias + colg + bj * HALF), b1 = *(const f32x4*)(bias + colg + bj * HALF + 4);
#pragma unroll
            for (int ai = 0; ai < 2; ++ai)
#pragma unroll
                for (int m = 0; m < 4; ++m) {
                    const int row = row0 + ai * HALF + m * 16;
                    f32x4 v0 = acc[ai][bj][m][0] + b0, v1 = acc[ai][bj][m][1] + b1;
                    if (rl) {
                        f32x4 p0, p1;
#pragma unroll
                        for (int e = 0; e < 4; ++e) { p0[e] = __shfl_xor(v0[e], 16); p1[e] = __shfl_xor(v1[e], 16); }
                        if (fq < 2) {
                            const f32x4 c0 = *(const f32x4*)(rope + (size_t)row * 16), c1 = *(const f32x4*)(rope + (size_t)row * 16 + 4);
                            const f32x4 s0 = *(const f32x4*)(rope + (size_t)row * 16 + 8), s1 = *(const f32x4*)(rope + (size_t)row * 16 + 12);
                            if (fq == 0) { v0 = v0 * c0 - p0 * s0; v1 = v1 * c1 - p1 * s1; }
                            else         { v0 = v0 * c0 + p0 * s0; v1 = v1 * c1 + p1 * s1; }
                        }
                    }
                    *(u32x4*)(base + (size_t)row * ldc + coll + bj * HALF) = pack8(v0, v1);
                    asm volatile("" ::: "memory");
                }
        }
    }
};

struct EpiXkv {
    static constexpr bool PERM = true, AFTER_DRAIN = false;
    bf16_t *Kx, *Vxt;
    __device__ __forceinline__ void operator()(const f32x4 (&acc)[2][2][4][2], const Unit& u, int wr, int wc, int fr, int fq) const {
        const int row0 = u.pm * BM + wr * 64 + fr; const int pn = u.pn;
#pragma unroll
        for (int bj = 0; bj < 2; ++bj)
#pragma unroll
            for (int ai = 0; ai < 2; ++ai)
#pragma unroll
                for (int m = 0; m < 4; ++m) {
                    const int row = row0 + ai * HALF + m * 16, b = row >> 8, key = row & 255;
                    const int d0 = bj * HALF + wc * 32 + 8 * fq;
                    const u32x4 w = pack8(acc[ai][bj][m][0], acc[ai][bj][m][1]);
                    if (pn < 4) { *(u32x4*)(Kx + ((size_t)(b * 4 + pn) * 256 + key) * 256 + d0) = w; }
                    else { bf16_t* vp = Vxt + ((size_t)(b * 4 + (pn - 4)) * 256 + d0) * 256 + key;
                        vp[0] = (bf16_t)(w.x & 0xffffu); vp[256] = (bf16_t)(w.x >> 16); vp[512] = (bf16_t)(w.y & 0xffffu); vp[768] = (bf16_t)(w.y >> 16);
                        vp[1024] = (bf16_t)(w.z & 0xffffu); vp[1280] = (bf16_t)(w.z >> 16); vp[1536] = (bf16_t)(w.w & 0xffffu); vp[1792] = (bf16_t)(w.w >> 16); }
                }
    }
};

struct EpiGlu {
    static constexpr bool PERM = true, AFTER_DRAIN = false;
    bf16_t* MIX; const bf16_t* GS; const float* bias;
    __device__ __forceinline__ void operator()(const f32x4 (&acc)[2][2][4][2], const Unit& u, int wr, int wc, int fr, int fq) const {
        const int row0 = u.pm * BM + wr * 64 + fr, col = u.pn * HALF + wc * 32 + 8 * fq;
        const f32x4 bv0 = *(const f32x4*)(bias + col), bv1 = *(const f32x4*)(bias + col + 4), bg0 = *(const f32x4*)(bias + 1024 + col), bg1 = *(const f32x4*)(bias + 1024 + col + 4);
#pragma unroll
        for (int ai = 0; ai < 2; ++ai)
#pragma unroll
            for (int m = 0; m < 4; ++m) {
                const size_t off = (size_t)(row0 + ai * HALF + m * 16) * 1024 + col;
                f32x4 g0, g1; unpack8(*(const u32x4*)(GS + off), g0, g1);
                const f32x4 a0 = acc[ai][0][m][0] + bv0, a1 = acc[ai][0][m][1] + bv1, t0 = acc[ai][1][m][0] + bg0, t1 = acc[ai][1][m][1] + bg1;
                f32x4 o0, o1;
#pragma unroll
                for (int e = 0; e < 4; ++e) { o0[e] = sigmoidf_(g0[e]) * a0[e] * sigmoidf_(t0[e]); o1[e] = sigmoidf_(g1[e]) * a1[e] * sigmoidf_(t1[e]); }
                *(u32x4*)(MIX + off) = pack8(o0, o1);
                asm volatile("" ::: "memory");
            }
    }
};

typedef unsigned u32x2_ __attribute__((ext_vector_type(2)));
struct EpiUp {
    static constexpr bool PERM = true, AFTER_DRAIN = false;
    bf16_t* MIX; const bf16_t* GA;
    __device__ __forceinline__ void operator()(const f32x4 (&acc)[2][2][4][2], const Unit& u, int wr, int wc, int fr, int fq) const {
        const int row0 = u.pm * BM + wr * 64 + fr, col0 = u.pn * BM + wc * 32 + 8 * fq;
#pragma unroll
        for (int bj = 0; bj < 2; ++bj)
#pragma unroll
            for (int ai = 0; ai < 2; ++ai)
#pragma unroll
                for (int m = 0; m < 4; ++m)
#pragma unroll
                    for (int n = 0; n < 2; ++n) {
                        const size_t off = (size_t)(row0 + ai * HALF + m * 16) * 1024 + col0 + bj * HALF + 4 * n;
                        const u32x2_ g = *(const u32x2_*)(GA + off), x = *(const u32x2_*)(MIX + off);
                        const f32x4 a = acc[ai][bj][m][n];
                        const float r0 = __uint_as_float(x.x << 16) + sigmoidf_(__uint_as_float(g.x << 16)) * a[0];
                        const float r1 = __uint_as_float(x.x & 0xffff0000u) + sigmoidf_(__uint_as_float(g.x & 0xffff0000u)) * a[1];
                        const float r2 = __uint_as_float(x.y << 16) + sigmoidf_(__uint_as_float(g.y << 16)) * a[2];
                        const float r3 = __uint_as_float(x.y & 0xffff0000u) + sigmoidf_(__uint_as_float(g.y & 0xffff0000u)) * a[3];
                        u32x2_ o; o.x = cvt_pk_bf16(r0, r1); o.y = cvt_pk_bf16(r2, r3);
                        *(u32x2_*)(MIX + off) = o;
                        asm volatile("" ::: "memory");
                    }
    }
};

struct EpiRes {
    static constexpr bool PERM = true, AFTER_DRAIN = false;
    float* R; const float* bias; float alpha;
    __device__ __forceinline__ void operator()(const f32x4 (&acc)[2][2][4][2], const Unit& u, int wr, int wc, int fr, int fq) const {
        const int row0 = u.pm * BM + wr * 64 + fr, col0 = u.pn * BM + wc * 32 + 8 * fq;
#pragma unroll
        for (int bj = 0; bj < 2; ++bj) {
            f32x4 b0 = (f32x4){0.f, 0.f, 0.f, 0.f}, b1 = b0;
            if (bias) { b0 = *(const f32x4*)(bias + col0 + bj * HALF); b1 = *(const f32x4*)(bias + col0 + bj * HALF + 4); }
#pragma unroll
            for (int ai = 0; ai < 2; ++ai)
#pragma unroll
                for (int m = 0; m < 4; ++m) {
                    float* p = R + (size_t)(row0 + ai * HALF + m * 16) * 1024 + col0 + bj * HALF;
                    const f32x4 r0 = *(const f32x4*)p, r1 = *(const f32x4*)(p + 4);
                    *(f32x4*)p = r0 * alpha + acc[ai][bj][m][0] + b0; *(f32x4*)(p + 4) = r1 * alpha + acc[ai][bj][m][1] + b1;
                    asm volatile("" ::: "memory");
                }
        }
    }
};
template <class Epi, class Sched, bool ALIGN_EPI = false, bool SP2 = false>
__device__ __forceinline__ void gemm_phase(PG8_LAS unsigned char* lds, const Gemm g, const Sched& S, const Epi& E) {
    const int tid = threadIdx.x, wid = __builtin_amdgcn_readfirstlane(tid >> 6), lane = tid & 63, wr = wid >> 2, wc = wid & 3, fr = lane & 15, fq = lane >> 4;
    const int K = g.K, nt = K / BK;
    unsigned voffA[2], voffB[2];
#pragma unroll
    for (int i = 0; i < 2; ++i) { int R, C; stage_rc(tid * 16 + i * 8192, R, C); const int Rb = Epi::PERM ? ((R & ~31) + perm32(R & 31)) : R;
        voffA[i] = (unsigned)(R * K + C) * 2u; voffB[i] = (unsigned)(Rb * K + C) * 2u; }
    const size_t kstep = (size_t)(BK * 2);
    const size_t hstep = (size_t)HALF * K * 2;
    const size_t tstep = 2 * hstep;
    const unsigned ldsw = (unsigned)wid * 1024u;
    const int aoff = lds_byte(wr * 64 + fr, fq * 8), boff = lds_byte(wc * 32 + fr, fq * 8);
#define PG8_SA(b, h) (((b) * 2 + (h)) * HTB)
#define PG8_SB(b, h) ((4 + (b) * 2 + (h)) * HTB)
#define PG8_STAGE(bufoff, gbase, voff) do { _Pragma("unroll") for (int _i = 0; _i < 2; ++_i) \
        __builtin_amdgcn_global_load_lds((const unsigned*)((const char*)(gbase) + (voff)[_i]), (PG8_LAS unsigned*)(lds + (bufoff) + ldsw + _i * 8192), 16, 0, 0); } while (0)
#define PG8_LDA(dst, b, h) do { _Pragma("unroll") for (int m = 0; m < 4; ++m) _Pragma("unroll") for (int k = 0; k < 2; ++k) dst[m][k] = *(const PG8_LAS bf16x8*)(lds + PG8_SA(b, h) + aoff + m * 2048 + k * 1024); } while (0)
#define PG8_LDB(dst, b, h) do { _Pragma("unroll") for (int n = 0; n < 2; ++n) _Pragma("unroll") for (int k = 0; k < 2; ++k) dst[n][k] = *(const PG8_LAS bf16x8*)(lds + PG8_SB(b, h) + boff + n * 2048 + k * 1024); } while (0)
#define PG8_MMA(ai, bj, At, Bt) do { __builtin_amdgcn_s_setprio(1); _Pragma("unroll") for (int m = 0; m < 4; ++m) _Pragma("unroll") for (int n = 0; n < 2; ++n) _Pragma("unroll") for (int k = 0; k < 2; ++k) \
        acc[ai][bj][m][n] = __builtin_amdgcn_mfma_f32_16x16x32_bf16(Bt[n][k], At[m][k], acc[ai][bj][m][n], 0, 0, 0); __builtin_amdgcn_s_setprio(0); } while (0)
#define PG8_WAIT_V(n) asm volatile("s_waitcnt vmcnt(" #n ")" ::: "memory")
#define PG8_WAIT_L(n) asm volatile("s_waitcnt lgkmcnt(" #n ")" ::: "memory")
#define PG8_BAR __builtin_amdgcn_s_barrier()
#define PG8_SCHED __builtin_amdgcn_sched_barrier(0)
    Unit cur, nxt; int ui = 0;
    if (!S.next(0, cur)) return;
    f32x4 acc[2][2][4][2];
#pragma unroll
    for (int a = 0; a < 2; ++a)
#pragma unroll
        for (int b = 0; b < 2; ++b)
#pragma unroll
            for (int m = 0; m < 4; ++m)
#pragma unroll
                for (int n = 0; n < 2; ++n) acc[a][b][m][n] = (f32x4){0.f, 0.f, 0.f, 0.f};
    bf16x8 At[4][2], B0[2][2], B1[2][2];
    const char* cA = (const char*)g.A + (size_t)cur.pm * tstep; const char* cB = (const char*)g.Bt + (size_t)cur.pn * tstep;
    S.a_ready(cur);
    if constexpr (SP2) {
        PG8_STAGE(PG8_SB(0, 0), cB, voffB); PG8_STAGE(PG8_SB(0, 1), cB + hstep, voffB); PG8_STAGE(PG8_SA(0, 0), cA, voffA); PG8_STAGE(PG8_SA(0, 1), cA + hstep, voffA);
        if (wr == 1) PG8_BAR;
        PG8_WAIT_V(2); PG8_BAR;
        PG8_STAGE(PG8_SB(1, 0), cB + kstep, voffB); PG8_STAGE(PG8_SA(1, 0), cA + kstep, voffA); PG8_STAGE(PG8_SB(1, 1), cB + hstep + kstep, voffB);
        PG8_WAIT_V(6); PG8_BAR;
    } else {
        PG8_STAGE(PG8_SB(0, 0), cB, voffB); PG8_STAGE(PG8_SA(0, 0), cA, voffA); PG8_STAGE(PG8_SB(0, 1), cB + hstep, voffB); PG8_STAGE(PG8_SA(0, 1), cA + hstep, voffA);
        if (wr == 1) PG8_BAR;
        PG8_WAIT_V(4); PG8_BAR;
        PG8_STAGE(PG8_SB(1, 0), cB + kstep, voffB); PG8_STAGE(PG8_SA(1, 0), cA + kstep, voffA); PG8_STAGE(PG8_SB(1, 1), cB + hstep + kstep, voffB);
        PG8_WAIT_V(6); PG8_BAR;
    }
    for (;;) {
        const bool has_next = S.next(ui + 1, nxt);
        const char* nA = has_next ? (const char*)g.A + (size_t)nxt.pm * tstep : cA; const char* nB = has_next ? (const char*)g.Bt + (size_t)nxt.pn * tstep : cB;
        for (int t = 0; t < nt; t += 2) {
            const bool last = (t == nt - 2);
            const char* a1 = cA + (size_t)(t + 1) * kstep;
            const char* a2 = last ? nA : cA + (size_t)(t + 2) * kstep; const char* b2 = last ? nB : cB + (size_t)(t + 2) * kstep;
            const char* a3 = a2 + kstep; const char* b3 = b2 + kstep;
            if (last && has_next) S.a_ready(nxt);
            if constexpr (SP2) {
            PG8_LDB(B0, 0, 0); PG8_LDB(B1, 0, 1); PG8_SCHED; PG8_LDA(At, 0, 0); PG8_STAGE(PG8_SA(1, 1), a1 + hstep, voffA);
            PG8_WAIT_V(8); PG8_WAIT_L(0); PG8_BAR; PG8_MMA(0, 0, At, B0); PG8_MMA(0, 1, At, B1); PG8_BAR; PG8_SCHED;
            PG8_LDA(At, 0, 1); PG8_STAGE(PG8_SB(0, 0), b2, voffB); PG8_STAGE(PG8_SB(0, 1), b2 + hstep, voffB); PG8_STAGE(PG8_SA(0, 0), a2, voffA);
            PG8_WAIT_V(8); PG8_WAIT_L(0); PG8_BAR; PG8_MMA(1, 0, At, B0); PG8_MMA(1, 1, At, B1); PG8_BAR; PG8_SCHED;
            PG8_LDB(B0, 1, 0); PG8_LDB(B1, 1, 1); PG8_SCHED; PG8_LDA(At, 1, 0); PG8_STAGE(PG8_SA(0, 1), a2 + hstep, voffA);
            PG8_WAIT_V(8); PG8_WAIT_L(0); PG8_BAR; PG8_MMA(0, 0, At, B0); PG8_MMA(0, 1, At, B1); PG8_BAR; PG8_SCHED;
            PG8_LDA(At, 1, 1); PG8_STAGE(PG8_SB(1, 0), b3, voffB); PG8_STAGE(PG8_SB(1, 1), b3 + hstep, voffB); PG8_STAGE(PG8_SA(1, 0), a3, voffA);
            PG8_WAIT_V(8); PG8_WAIT_L(0); PG8_BAR; PG8_MMA(1, 0, At, B0); PG8_MMA(1, 1, At, B1); PG8_BAR; PG8_SCHED;
            } else {
            PG8_LDB(B0, 0, 0); PG8_SCHED; PG8_LDA(At, 0, 0); PG8_STAGE(PG8_SA(1, 1), a1 + hstep, voffA);
            PG8_WAIT_L(8); PG8_BAR; PG8_WAIT_L(0); PG8_MMA(0, 0, At, B0); PG8_BAR; PG8_SCHED;
            PG8_LDB(B1, 0, 1); PG8_STAGE(PG8_SB(0, 0), b2, voffB);
            PG8_BAR; PG8_WAIT_L(0); PG8_MMA(0, 1, At, B1); PG8_BAR;
            PG8_LDA(At, 0, 1); PG8_STAGE(PG8_SA(0, 0), a2, voffA);
            PG8_BAR; PG8_WAIT_L(0); PG8_MMA(1, 0, At, B0); PG8_BAR; PG8_SCHED;
            PG8_STAGE(PG8_SB(0, 1), b2 + hstep, voffB);
            PG8_WAIT_V(6); PG8_BAR; PG8_MMA(1, 1, At, B1); PG8_BAR;
            PG8_LDB(B0, 1, 0); PG8_SCHED; PG8_LDA(At, 1, 0); PG8_STAGE(PG8_SA(0, 1), a2 + hstep, voffA);
            PG8_WAIT_L(8); PG8_BAR; PG8_WAIT_L(0); PG8_MMA(0, 0, At, B0); PG8_BAR; PG8_SCHED;
            PG8_LDB(B1, 1, 1); PG8_STAGE(PG8_SB(1, 0), b3, voffB);
            PG8_BAR; PG8_WAIT_L(0); PG8_MMA(0, 1, At, B1); PG8_BAR;
            PG8_LDA(At, 1, 1); PG8_STAGE(PG8_SA(1, 0), a3, voffA);
            PG8_BAR; PG8_WAIT_L(0); PG8_MMA(1, 0, At, B0); PG8_BAR; PG8_SCHED;
            PG8_STAGE(PG8_SB(1, 1), b3 + hstep, voffB);
            PG8_WAIT_V(6); PG8_BAR; PG8_MMA(1, 1, At, B1); PG8_BAR;
            }
        }
        if constexpr (ALIGN_EPI) { if (wr == 0) PG8_BAR; }
        if constexpr (!Epi::AFTER_DRAIN) { E(acc, cur, wr, wc, fr, fq); S.done(cur); }
        if (!has_next) break;
#pragma unroll
        for (int a = 0; a < 2; ++a)
#pragma unroll
            for (int b = 0; b < 2; ++b)
#pragma unroll
                for (int m = 0; m < 4; ++m)
#pragma unroll
                    for (int n = 0; n < 2; ++n) acc[a][b][m][n] = (f32x4){0.f, 0.f, 0.f, 0.f};
        cur = nxt; cA = nA; cB = nB; ++ui;
        if constexpr (ALIGN_EPI) { if (wr == 1) PG8_BAR; }
    }
    PG8_WAIT_V(0);
    if constexpr (!ALIGN_EPI) { if (wr == 0) PG8_BAR; }
    PG8_BAR;
    if constexpr (Epi::AFTER_DRAIN) { E.fused(acc, cur, wr, wc, fr, fq, lds, wid, lane); S.done(cur); }
#undef PG8_SA
#undef PG8_SB
#undef PG8_STAGE
#undef PG8_LDA
#undef PG8_LDB
#undef PG8_MMA
#undef PG8_WAIT_V
#undef PG8_WAIT_L
#undef PG8_BAR
#undef PG8_SCHED
}
}
#define LAS __attribute__((address_space(3)))
typedef unsigned short bf16;
typedef short bf16x8 __attribute__((ext_vector_type(8)));
typedef short s16x4 __attribute__((ext_vector_type(4)));
typedef float f32x4 __attribute__((ext_vector_type(4)));
typedef float f32x2 __attribute__((ext_vector_type(2)));
typedef unsigned u32x4 __attribute__((ext_vector_type(4)));
typedef unsigned u32x2 __attribute__((ext_vector_type(2)));

constexpr int NW = 8, NT = 512;
constexpr int M = 16384, D = 1024, SEQ = 4096, NB = 4, FF = 4096, INC = 5120;
constexpr float LN_EPS = 1e-5f;
constexpr float ALPHA = 1.189207115002721f;
constexpr float LOG2E = 1.4426950408889634f, LN2 = 0.6931471805599453f;
constexpr size_t MiB = 1u << 20;
constexpr size_t WS_CTL = 0, CTL_ZERO = 4096, WS_LSE = 128 * 1024;
constexpr size_t WS_W_IN = 1 * MiB, WS_W_GLU = 11 * MiB, WS_W_UP = 14 * MiB, WS_W_MIX = 15 * MiB, WS_W_XQ = 17 * MiB, WS_W_XKV = 19 * MiB, WS_W_XO = 23 * MiB,
                 WS_W_FF1 = 25 * MiB, WS_W_FF2 = 33 * MiB, WS_ROPE = 41 * MiB, WS_MEMB = 42 * MiB, WS_KX = 44 * MiB, WS_VXT = 46 * MiB;
constexpr size_t WS_H0B = 48 * MiB;
constexpr size_t WS_YS = 48 * MiB, WS_OG0 = 72 * MiB, WS_H2B = 48 * MiB;
constexpr size_t WS_U = 80 * MiB, WS_Q = 104 * MiB, WS_K = 128 * MiB, WS_V = 152 * MiB, WS_GS = 176 * MiB, WS_GA = 208 * MiB, WS_OG1 = 240 * MiB, WS_OG2 = 248 * MiB;
constexpr size_t WS_MIX = 80 * MiB, WS_ATT = 112 * MiB, WS_H1B = 128 * MiB, WS_QX = 160 * MiB, WS_XO = 192 * MiB, WS_FFH = 80 * MiB;
constexpr int LDS_BYTES = 147456;

__device__ __forceinline__ unsigned pk2(float lo, float hi) { return pg8::cvt_pk_bf16(lo, hi); }
__device__ __forceinline__ float bf2f(unsigned short h) { return __uint_as_float(((unsigned)h) << 16); }
__device__ __forceinline__ float wave_sum(float v) {
#pragma unroll
    for (int o = 1; o < 64; o <<= 1) v += __shfl_xor(v, o);
    return v;
}
#define LDS_WAIT() asm volatile("s_waitcnt lgkmcnt(0)" ::: "memory")

struct Args { const void* in[33]; float* out; unsigned char* ws; };

__device__ __forceinline__ void p0_transpose_item(const float* W, int K, int N, bf16* WT, int k0, int n0, int drow0, LAS float* scr, int lane) {
#pragma unroll 8
    for (int i = 0; i < 32; ++i) { const int kk = 2 * i + (lane >> 5); scr[kk * 33 + (lane & 31)] = W[(size_t)(k0 + kk) * N + n0 + (lane & 31)]; }
    LDS_WAIT();
    const int c = lane & 7;
#pragma unroll
    for (int j = 0; j < 4; ++j) { const int n = (lane >> 3) + 8 * j; const LAS float* s = scr + (8 * c) * 33 + n;
        u32x4 o; o.x = pk2(s[0 * 33], s[1 * 33]); o.y = pk2(s[2 * 33], s[3 * 33]); o.z = pk2(s[4 * 33], s[5 * 33]); o.w = pk2(s[6 * 33], s[7 * 33]);
        *(u32x4*)(WT + (size_t)(drow0 + n) * K + k0 + 8 * c) = o; }
    LDS_WAIT();
}
__device__ __forceinline__ void p0_matrix(const float* W, int K, int N, bf16* WT, bool glu, LAS float* scr, int lane, int it) {
    const int nblk = N / 32, kb = it / nblk, nb = it % nblk, n0 = 32 * nb;
    int drow0 = n0;
    if (glu) { const int half = n0 >> 10, c = n0 & 1023; drow0 = (c >> 7) * 256 + half * 128 + (c & 127); }
    p0_transpose_item(W, K, N, WT, 64 * kb, n0, drow0, scr, lane);
}
__device__ __forceinline__ void ln_row(const float* xrow, const float* g, const float* b, float* of, bf16* ob, int lane) {
    const f32x4* xr = (const f32x4*)xrow + lane;
    f32x4 v[4]; float s = 0.f;
#pragma unroll
    for (int j = 0; j < 4; ++j) { v[j] = xr[64 * j]; s += (v[j].x + v[j].y) + (v[j].z + v[j].w); }
    const float mean = wave_sum(s) * (1.f / D); float s2 = 0.f;
#pragma unroll
    for (int j = 0; j < 4; ++j) { v[j] = v[j] - mean; s2 += (v[j].x * v[j].x + v[j].y * v[j].y) + (v[j].z * v[j].z + v[j].w * v[j].w); }
    const float rstd = 1.f / sqrtf(wave_sum(s2) * (1.f / D) + LN_EPS);
#pragma unroll
    for (int j = 0; j < 4; ++j) {
        const f32x4 gg = ((const f32x4*)g)[lane + 64 * j], bb = ((const f32x4*)b)[lane + 64 * j];
        const f32x4 y = v[j] * rstd * gg + bb;
        if (of) ((f32x4*)of)[lane + 64 * j] = y;
        if (ob) { u32x2 w; w.x = pk2(y.x, y.y); w.y = pk2(y.z, y.w); ((u32x2*)ob)[lane + 64 * j] = w; }
    }
}

__device__ __forceinline__ float gelu_tanh(float x) { const float z = 0.7978845608028654f * (x + 0.044715f * x * x * x); return x / (1.0f + __expf(-2.0f * z)); }

__device__ __forceinline__ void ssm_unit(const Args& A, int b, int g, LAS unsigned char* lds) {
    const int tid = threadIdx.x, lane = tid & 63, w = __builtin_amdgcn_readfirstlane(tid >> 6), fr = lane & 15, fq = lane >> 4;
    const float* log_dt = (const float*)A.in[7]; const float* a_re = (const float*)A.in[8]; const float* a_im = (const float*)A.in[9];
    const float* b_re = (const float*)A.in[10]; const float* b_im = (const float*)A.in[11]; const float* c_re = (const float*)A.in[12]; const float* c_im = (const float*)A.in[13];
    const float* dsk = (const float*)A.in[14];
    const bf16* U = (const bf16*)(A.ws + WS_U); bf16* YS = (bf16*)(A.ws + WS_YS);
    LAS float* Wl = (LAS float*)(lds + w * 12800);
    LAS bf16* Hl = (LAS bf16*)(lds + w * 12800 + 8448);
    LAS float* Cl = (LAS float*)(lds + 8 * 12800);
    const float dt = __expf(log_dt[g]);
    float lr, li;
    { const float are = a_re[g * 64 + lane], aim = a_im[g * 64 + lane]; const float mag = __expf(are * dt); lr = mag * cosf(aim * dt); li = mag * sinf(aim * dt); }
    s16x4 abr[4], abi[4];
#pragma unroll
    for (int nb = 0; nb < 4; ++nb) {
        const int n = 16 * nb + fr; const float are = a_re[g * 64 + n], aim = a_im[g * 64 + n];
        const float mag = __expf(are * dt), xr = mag * cosf(aim * dt), xi = mag * sinf(aim * dt), den = are * are + aim * aim, nr = xr - 1.0f;
        const float fre = (nr * are + xi * aim) / den, fim = (xi * are - nr * aim) / den;
        const f32x4 br = *(const f32x4*)(b_re + ((size_t)g * 64 + n) * 16 + 4 * fq), bi = *(const f32x4*)(b_im + ((size_t)g * 64 + n) * 16 + 4 * fq);
        const f32x4 bbr = br * fre - bi * fim, bbi = bi * fre + br * fim;
        u32x2 t; t.x = pk2(bbr[0], bbr[1]); t.y = pk2(bbr[2], bbr[3]); abr[nb] = __builtin_bit_cast(s16x4, t);
        t.x = pk2(bbi[0], bbi[1]); t.y = pk2(bbi[2], bbi[3]); abi[nb] = __builtin_bit_cast(s16x4, t);
    }
    bf16x8 cf[4];
#pragma unroll
    for (int kb = 0; kb < 4; ++kb) {
        const float* src = (kb < 2 ? c_re : c_im) + ((size_t)g * 16 + fr) * 64 + (kb & 1) * 32 + 8 * fq;
        f32x4 x0 = *(const f32x4*)src, x1 = *(const f32x4*)(src + 4);
        if (kb >= 2) { x0 = -x0; x1 = -x1; }
        cf[kb] = __builtin_bit_cast(bf16x8, pg8::pack8(x0, x1));
    }
    const f32x4 dv = *(const f32x4*)(dsk + 16 * g + 4 * fq);
    const size_t rowbase = (size_t)b * SEQ + (size_t)w * 512;
    float hr = 0.f, hi = 0.f;
    for (int tile = 0; tile < 32; ++tile) {
        const s16x4 uf = *(const s16x4*)(U + (rowbase + tile * 16 + fr) * 768 + 16 * g + 4 * fq);
#pragma unroll
        for (int nb = 0; nb < 4; ++nb) {
            const f32x4 z = (f32x4){0.f, 0.f, 0.f, 0.f};
            const f32x4 wre = __builtin_amdgcn_mfma_f32_16x16x16bf16_1k(abr[nb], uf, z, 0, 0, 0);
            const f32x4 wim = __builtin_amdgcn_mfma_f32_16x16x16bf16_1k(abi[nb], uf, z, 0, 0, 0);
            *(LAS f32x4*)(Wl + fr * 132 + 16 * nb + 4 * fq) = wre; *(LAS f32x4*)(Wl + fr * 132 + 64 + 16 * nb + 4 * fq) = wim;
        }
        LDS_WAIT();
#pragma unroll
        for (int t = 0; t < 16; ++t) { const float wr_ = Wl[t * 132 + lane], wi_ = Wl[t * 132 + 64 + lane];
            const float nr = lr * hr - li * hi + wr_, ni = lr * hi + li * hr + wi_; hr = nr; hi = ni; }
        LDS_WAIT();
    }
    Cl[w * 128 + lane] = hr; Cl[w * 128 + 64 + lane] = hi;
    float pr = lr, pi = li;
#pragma unroll
    for (int i = 0; i < 9; ++i) { const float nr = pr * pr - pi * pi, ni = 2.0f * pr * pi; pr = nr; pi = ni; }
    __syncthreads();
    hr = 0.f; hi = 0.f;
    for (int v = 0; v < w; ++v) { const float er = Cl[v * 128 + lane], ei = Cl[v * 128 + 64 + lane]; const float nr = pr * hr - pi * hi + er, ni = pr * hi + pi * hr + ei; hr = nr; hi = ni; }
    for (int tile = 0; tile < 32; ++tile) {
        const s16x4 uf = *(const s16x4*)(U + (rowbase + tile * 16 + fr) * 768 + 16 * g + 4 * fq);
#pragma unroll
        for (int nb = 0; nb < 4; ++nb) {
            const f32x4 z = (f32x4){0.f, 0.f, 0.f, 0.f};
            const f32x4 wre = __builtin_amdgcn_mfma_f32_16x16x16bf16_1k(abr[nb], uf, z, 0, 0, 0);
            const f32x4 wim = __builtin_amdgcn_mfma_f32_16x16x16bf16_1k(abi[nb], uf, z, 0, 0, 0);
            *(LAS f32x4*)(Wl + fr * 132 + 16 * nb + 4 * fq) = wre; *(LAS f32x4*)(Wl + fr * 132 + 64 + 16 * nb + 4 * fq) = wim;
        }
        LDS_WAIT();
#pragma unroll
        for (int t = 0; t < 16; ++t) { const float wr_ = Wl[t * 132 + lane], wi_ = Wl[t * 132 + 64 + lane];
            const float nr = lr * hr - li * hi + wr_, ni = lr * hi + li * hr + wi_; hr = nr; hi = ni;
            Hl[t * 136 + lane] = (bf16)(pk2(hr, 0.f) & 0xffffu); Hl[t * 136 + 64 + lane] = (bf16)(pk2(hi, 0.f) & 0xffffu); }
        LDS_WAIT();
        f32x4 y = (f32x4){0.f, 0.f, 0.f, 0.f};
#pragma unroll
        for (int kb = 0; kb < 4; ++kb) { const bf16x8 hf = *(const LAS bf16x8*)(Hl + fr * 136 + 32 * kb + 8 * fq); y = __builtin_amdgcn_mfma_f32_16x16x32_bf16(cf[kb], hf, y, 0, 0, 0); }
        f32x4 o;
#pragma unroll
        for (int j = 0; j < 4; ++j) o[j] = gelu_tanh(y[j] + dv[j] * bf2f((unsigned short)uf[j]));
        u32x2 pk; pk.x = pk2(o[0], o[1]); pk.y = pk2(o[2], o[3]);
        *(u32x2*)(YS + (rowbase + tile * 16 + fr) * 768 + 16 * g + 4 * fq) = pk;
        LDS_WAIT();
    }
    __syncthreads();
}

__device__ __forceinline__ void attn_unit(const Args& A, int gi, int b, int hh, int blk, LAS unsigned char* lds) {
    const int tid = threadIdx.x, lane = tid & 63, w = __builtin_amdgcn_readfirstlane(tid >> 6), fr = lane & 15, fq = lane >> 4;
    const int d = (gi == 0) ? 1 : (gi == 1 ? 4 : 16);
    const int r = blk % d, n = blk / d;
    const int hc = (gi * 4 + hh) * 64;
    const bf16* Q = (const bf16*)(A.ws + WS_Q); const bf16* K = (const bf16*)(A.ws + WS_K); const bf16* V = (const bf16*)(A.ws + WS_V);
    bf16* OG = (bf16*)(A.ws + (gi == 0 ? WS_OG0 : (gi == 1 ? WS_OG1 : WS_OG2)));
    float* LSE = (float*)(A.ws + WS_LSE) + (size_t)gi * M * 4;
    LAS unsigned char* Kl = lds;
    LAS unsigned char* Vl = lds + 256 * 144;
#pragma unroll
    for (int j = 0; j < 4; ++j) {
        const int p = tid + 512 * j, key = p >> 3, ch = p & 7;
        const int mi = (n - 1) * 128 + key;
        u32x4 kv = (u32x4){0u, 0u, 0u, 0u}, vv = kv;
        if (mi >= 0) { const size_t row = (size_t)b * SEQ + (size_t)mi * d + r; kv = *(const u32x4*)(K + row * 768 + hc + ch * 8); vv = *(const u32x4*)(V + row * 768 + hc + ch * 8); }
        *(LAS u32x4*)(Kl + key * 144 + ch * 16) = kv;
        LAS bf16* vt = (LAS bf16*)(Vl + (ch * 8) * 528 + key * 2);
        vt[0 * 264] = (bf16)(vv.x & 0xffffu); vt[1 * 264] = (bf16)(vv.x >> 16); vt[2 * 264] = (bf16)(vv.y & 0xffffu); vt[3 * 264] = (bf16)(vv.y >> 16);
        vt[4 * 264] = (bf16)(vv.z & 0xffffu); vt[5 * 264] = (bf16)(vv.z >> 16); vt[6 * 264] = (bf16)(vv.w & 0xffffu); vt[7 * 264] = (bf16)(vv.w >> 16);
    }
    const int qi = 16 * w + fr;
    const size_t qrow = (size_t)b * SEQ + (size_t)(n * 128 + qi) * d + r;
    const bf16x8 q0 = *(const bf16x8*)(Q + qrow * 768 + hc + 8 * fq), q1 = *(const bf16x8*)(Q + qrow * 768 + hc + 32 + 8 * fq);
    __syncthreads();
    f32x4 s[9];
    const float SC = 0.125f * LOG2E;
    float mx = -3.0e38f;
#pragma unroll
    for (int t = 0; t < 9; ++t) {
        const int kt = w + t;
        const bf16x8 k0 = *(const LAS bf16x8*)(Kl + (kt * 16 + fr) * 144 + fq * 16), k1 = *(const LAS bf16x8*)(Kl + (kt * 16 + fr) * 144 + 64 + fq * 16);
        f32x4 a = (f32x4){0.f, 0.f, 0.f, 0.f};
        a = __builtin_amdgcn_mfma_f32_16x16x32_bf16(k0, q0, a, 0, 0, 0);
        a = __builtin_amdgcn_mfma_f32_16x16x32_bf16(k1, q1, a, 0, 0, 0);
#pragma unroll
        for (int j = 0; j < 4; ++j) { const int ki = kt * 16 + 4 * fq + j; const bool ok = (ki >= qi) && (ki <= qi + 128) && (n > 0 || ki >= 128);
            a[j] = ok ? a[j] * SC : -3.0e38f; mx = fmaxf(mx, a[j]); }
        s[t] = a;
    }
    mx = fmaxf(mx, __shfl_xor(mx, 16)); mx = fmaxf(mx, __shfl_xor(mx, 32));
    float den = 0.f;
#pragma unroll
    for (int t = 0; t < 9; ++t)
#pragma unroll
        for (int j = 0; j < 4; ++j) { const float p = __builtin_amdgcn_exp2f(s[t][j] - mx); s[t][j] = p; den += p; }
    den += __shfl_xor(den, 16); den += __shfl_xor(den, 32);
    f32x4 o[4];
#pragma unroll
    for (int db = 0; db < 4; ++db) o[db] = (f32x4){0.f, 0.f, 0.f, 0.f};
#pragma unroll
    for (int c = 0; c < 5; ++c) {
        const int t0 = 2 * c, t1 = 2 * c + 1;
        u32x4 pw; pw.x = pk2(s[t0][0], s[t0][1]); pw.y = pk2(s[t0][2], s[t0][3]);
        if (t1 < 9) { pw.z = pk2(s[t1 < 9 ? t1 : 0][0], s[t1 < 9 ? t1 : 0][1]); pw.w = pk2(s[t1 < 9 ? t1 : 0][2], s[t1 < 9 ? t1 : 0][3]); } else { pw.z = 0u; pw.w = 0u; }
        const bf16x8 pf = __builtin_bit_cast(bf16x8, pw);
#pragma unroll
        for (int db = 0; db < 4; ++db) {
            u32x4 vw;
            const u32x2 lo = *(const LAS u32x2*)(Vl + (db * 16 + fr) * 528 + ((w + t0) * 16 + 4 * fq) * 2);
            vw.x = lo.x; vw.y = lo.y;
            if (t1 < 9) { const u32x2 hi2 = *(const LAS u32x2*)(Vl + (db * 16 + fr) * 528 + ((w + t1) * 16 + 4 * fq) * 2); vw.z = hi2.x; vw.w = hi2.y; } else { vw.z = 0u; vw.w = 0u; }
            o[db] = __builtin_amdgcn_mfma_f32_16x16x32_bf16(__builtin_bit_cast(bf16x8, vw), pf, o[db], 0, 0, 0);
        }
    }
    const float inv = 1.0f / den;
#pragma unroll
    for (int db = 0; db < 4; ++db) { u32x2 pk; pk.x = pk2(o[db][0] * inv, o[db][1] * inv); pk.y = pk2(o[db][2] * inv, o[db][3] * inv);
        *(u32x2*)(OG + qrow * 256 + hh * 64 + db * 16 + 4 * fq) = pk; }
    if (fq == 0) LSE[qrow * 4 + hh] = (mx + __builtin_amdgcn_logf(den)) * LN2;
    __syncthreads();
}

__device__ __forceinline__ void xattn_unit(const Args& A, int b, int xh, int qb, LAS unsigned char* lds) {
    const int tid = threadIdx.x, lane = tid & 63, w = __builtin_amdgcn_readfirstlane(tid >> 6), fr = lane & 15, fq = lane >> 4;
    const bf16* QX = (const bf16*)(A.ws + WS_QX); const bf16* KX = (const bf16*)(A.ws + WS_KX) + (size_t)(b * 4 + xh) * 65536; const bf16* VXT = (const bf16*)(A.ws + WS_VXT) + (size_t)(b * 4 + xh) * 65536;
    bf16* XO = (bf16*)(A.ws + WS_XO);
#pragma unroll 4
    for (int j = 0; j < 16; ++j) { const int p = tid + 512 * j, rw = p >> 5, ch = p & 31; *(LAS u32x4*)(lds + rw * 528 + ch * 16) = *(const u32x4*)(KX + (size_t)rw * 256 + ch * 8); }
    const size_t qrow = (size_t)b * SEQ + qb * 128 + 16 * w + fr;
    bf16x8 qf[8];
#pragma unroll
    for (int ks = 0; ks < 8; ++ks) qf[ks] = *(const bf16x8*)(QX + qrow * 1024 + xh * 256 + ks * 32 + 8 * fq);
    __syncthreads();
    f32x4 s[16];
    const float SC = 0.0625f * LOG2E;
    float mx = -3.0e38f;
#pragma unroll
    for (int kt = 0; kt < 16; ++kt) {
        f32x4 a = (f32x4){0.f, 0.f, 0.f, 0.f};
#pragma unroll
        for (int ks = 0; ks < 8; ++ks) { const bf16x8 kf = *(const LAS bf16x8*)(lds + (kt * 16 + fr) * 528 + ks * 64 + fq * 16); a = __builtin_amdgcn_mfma_f32_16x16x32_bf16(kf, qf[ks], a, 0, 0, 0); }
#pragma unroll
        for (int j = 0; j < 4; ++j) { a[j] *= SC; mx = fmaxf(mx, a[j]); }
        s[kt] = a;
    }
    mx = fmaxf(mx, __shfl_xor(mx, 16)); mx = fmaxf(mx, __shfl_xor(mx, 32));
    float den = 0.f;
    bf16x8 pf[8];
#pragma unroll
    for (int c = 0; c < 8; ++c) {
        f32x4 p0, p1;
#pragma unroll
        for (int j = 0; j < 4; ++j) { p0[j] = __builtin_amdgcn_exp2f(s[2 * c][j] - mx); p1[j] = __builtin_amdgcn_exp2f(s[2 * c + 1][j] - mx); den += p0[j] + p1[j]; }
        pf[c] = __builtin_bit_cast(bf16x8, pg8::pack8(p0, p1));
    }
    den += __shfl_xor(den, 16); den += __shfl_xor(den, 32);
    __syncthreads();
#pragma unroll 4
    for (int j = 0; j < 16; ++j) { const int p = tid + 512 * j, rw = p >> 5, ch = p & 31; *(LAS u32x4*)(lds + rw * 528 + ch * 16) = *(const u32x4*)(VXT + (size_t)rw * 256 + ch * 8); }
    __syncthreads();
    const float inv = 1.0f / den;
#pragma unroll
    for (int db = 0; db < 16; ++db) {
        f32x4 o = (f32x4){0.f, 0.f, 0.f, 0.f};
#pragma unroll
        for (int c = 0; c < 8; ++c) {
            const u32x2 lo = *(const LAS u32x2*)(lds + (db * 16 + fr) * 528 + (c * 32 + 4 * fq) * 2), hi2 = *(const LAS u32x2*)(lds + (db * 16 + fr) * 528 + (c * 32 + 16 + 4 * fq) * 2);
            u32x4 vw; vw.x = lo.x; vw.y = lo.y; vw.z = hi2.x; vw.w = hi2.y;
            o = __builtin_amdgcn_mfma_f32_16x16x32_bf16(__builtin_bit_cast(bf16x8, vw), pf[c], o, 0, 0, 0);
        }
        u32x2 pk; pk.x = pk2(o[0] * inv, o[1] * inv); pk.y = pk2(o[2] * inv, o[3] * inv);
        *(u32x2*)(XO + qrow * 1024 + xh * 256 + db * 16 + 4 * fq) = pk;
    }
    __syncthreads();
}

__global__ void __launch_bounds__(NT, 2) fwd_megakernel(Args A) {
    extern __shared__ __attribute__((aligned(16))) unsigned char lds_raw[];
    LAS unsigned char* lds = (LAS unsigned char*)lds_raw;
    cg::grid_group grid = cg::this_grid();
    const int tid = threadIdx.x, lane = tid & 63, wave = __builtin_amdgcn_readfirstlane(tid >> 6);
    const int G = gridDim.x, bx = blockIdx.x;
    const int gw = bx * NW + wave, NGW = G * NW;
    unsigned char* ws = A.ws;
    unsigned* ctl = (unsigned*)(ws + WS_CTL);
    LAS int* slot = (LAS int*)(lds + LDS_BYTES - 16);
    const float* x = (const float*)A.in[0];
    float* out = A.out;

    {
        LAS float* scr = (LAS float*)(lds + wave * 16384);
        constexpr int I0 = 16 * 160, I1 = 12 * 64, I2 = 4 * 32, I3 = 16 * 32, I4 = 16 * 32, I5 = 16 * 64, I6 = 16 * 32, I7 = 16 * 128, I8 = 64 * 32;
        constexpr int NITEMS = I0 + I1 + I2 + I3 + I4 + I5 + I6 + I7 + I8;
        for (int it = gw; it < NITEMS; it += NGW) {
            int r = it;
            if (r < I0) { p0_matrix((const float*)A.in[5], 1024, 5120, (bf16*)(ws + WS_W_IN), false, scr, lane, r); continue; } r -= I0;
            if (r < I1) { p0_matrix((const float*)A.in[15], 768, 2048, (bf16*)(ws + WS_W_GLU), true, scr, lane, r); continue; } r -= I1;
            if (r < I2) { p0_matrix((const float*)A.in[17], 256, 1024, (bf16*)(ws + WS_W_UP), false, scr, lane, r); continue; } r -= I2;
            if (r < I3) { p0_matrix((const float*)A.in[18], 1024, 1024, (bf16*)(ws + WS_W_MIX), false, scr, lane, r); continue; } r -= I3;
            if (r < I4) { p0_matrix((const float*)A.in[22], 1024, 1024, (bf16*)(ws + WS_W_XQ), false, scr, lane, r); continue; } r -= I4;
            if (r < I5) { p0_matrix((const float*)A.in[23], 1024, 2048, (bf16*)(ws + WS_W_XKV), false, scr, lane, r); continue; } r -= I5;
            if (r < I6) { p0_matrix((const float*)A.in[24], 1024, 1024, (bf16*)(ws + WS_W_XO), false, scr, lane, r); continue; } r -= I6;
            if (r < I7) { p0_matrix((const float*)A.in[27], 1024, 4096, (bf16*)(ws + WS_W_FF1), false, scr, lane, r); continue; } r -= I7;
            p0_matrix((const float*)A.in[29], 4096, 1024, (bf16*)(ws + WS_W_FF2), false, scr, lane, r);
        }
        for (int m = gw; m < M; m += NGW) ln_row(x + (size_t)m * D, (const float*)A.in[3], (const float*)A.in[4], out + (size_t)m * D, (bf16*)(ws + WS_H0B) + (size_t)m * D, lane);
        { const float* mem = (const float*)A.in[1]; bf16* mb = (bf16*)(ws + WS_MEMB);
          for (int i = bx * NT + tid; i < 1024 * 1024 / 8; i += G * NT) { const f32x4 a = ((const f32x4*)mem)[2 * i], c = ((const f32x4*)mem)[2 * i + 1]; ((u32x4*)mb)[i] = pg8::pack8(a, c); } }
        { const int* pos = (const int*)A.in[2]; float* rope = (float*)(ws + WS_ROPE);
          for (int i = bx * NT + tid; i < M * 8; i += G * NT) { const int row = i >> 3, k = i & 7;
              const float invf = (k == 0) ? 1.0f : (k == 1) ? 0.19392274f : (k == 2) ? 0.03760603f : (k == 3) ? 0.0072926646f : (k == 4) ? 0.0014142136f : (k == 5) ? 0.0002742482f : (k == 6) ? 5.3182957e-05f : 1.0313385e-05f;
              const float ang = (float)pos[row] * invf; rope[row * 16 + k] = cosf(ang); rope[row * 16 + 8 + k] = sinf(ang); } }
    }
    grid.sync();

    {
        pg8::Gemm g{(const pg8::bf16_t*)(ws + WS_H0B), (const pg8::bf16_t*)(ws + WS_W_IN), M, INC, D}; pg8::StaticOrder S; S.init(M, INC, G, bx);
        pg8::EpiProj E{(bf16*)(ws + WS_U), (bf16*)(ws + WS_Q), (bf16*)(ws + WS_K), (bf16*)(ws + WS_V), (bf16*)(ws + WS_GS), (bf16*)(ws + WS_GA), (const float*)A.in[6], (const float*)(ws + WS_ROPE)};
        pg8::gemm_phase<pg8::EpiProj, pg8::StaticOrder, true, true>(lds, g, S, E);
    }
    {
        pg8::Gemm g{(const pg8::bf16_t*)(ws + WS_MEMB), (const pg8::bf16_t*)(ws + WS_W_XKV), 1024, 2048, D}; pg8::StaticOrder S; S.init(1024, 2048, G, (bx + 128) % G);
        pg8::EpiXkv E{(bf16*)(ws + WS_KX), (bf16*)(ws + WS_VXT)};
        pg8::gemm_phase<pg8::EpiXkv, pg8::StaticOrder, true, true>(lds, g, S, E);
    }
    grid.sync();

    for (;;) {
        __syncthreads(); if (tid == 0) *slot = (int)atomicAdd(ctl + 0, 1u); __syncthreads();
        const int u = *slot;
        if (u >= 192 + 1536) break;
        if (u < 192) ssm_unit(A, u / 48, u % 48, lds);
        else { const int a = u - 192; attn_unit(A, a / 512, (a % 512) / 128, (a / 32) % 4, a % 32, lds); }
    }
    grid.sync();

    {
        const bf16* og0 = (const bf16*)(ws + WS_OG0); const bf16* og1 = (const bf16*)(ws + WS_OG1); const bf16* og2 = (const bf16*)(ws + WS_OG2);
        const float* lse = (const float*)(ws + WS_LSE); bf16* att = (bf16*)(ws + WS_ATT);
        for (int i = bx * NT + tid; i < M * 32; i += G * NT) {
            const int rh = i >> 3;
            const float l0 = lse[rh], l1 = lse[(size_t)M * 4 + rh], l2 = lse[(size_t)M * 8 + rh];
            const float mm = fmaxf(l0, fmaxf(l1, l2)); float w0 = __expf(l0 - mm), w1 = __expf(l1 - mm), w2 = __expf(l2 - mm); const float iz = 1.0f / (w0 + w1 + w2); w0 *= iz; w1 *= iz; w2 *= iz;
            f32x4 a0, a1, b0, b1, c0, c1; pg8::unpack8(((const u32x4*)og0)[i], a0, a1); pg8::unpack8(((const u32x4*)og1)[i], b0, b1); pg8::unpack8(((const u32x4*)og2)[i], c0, c1);
            ((u32x4*)att)[i] = pg8::pack8(a0 * w0 + b0 * w1 + c0 * w2, a1 * w0 + b1 * w1 + c1 * w2);
        }
        pg8::Gemm g{(const pg8::bf16_t*)(ws + WS_YS), (const pg8::bf16_t*)(ws + WS_W_GLU), M, 2048, 768}; pg8::StaticOrder S; S.init(M, 2048, G, bx);
        pg8::EpiGlu E{(bf16*)(ws + WS_MIX), (const bf16*)(ws + WS_GS), (const float*)A.in[16]};
        pg8::gemm_phase<pg8::EpiGlu, pg8::StaticOrder, true, true>(lds, g, S, E);
    }
    grid.sync();

    {
        int kup = 256; asm volatile("" : "+s"(kup));
        pg8::Gemm g{(const pg8::bf16_t*)(ws + WS_ATT), (const pg8::bf16_t*)(ws + WS_W_UP), M, D, kup}; pg8::StaticOrder S; S.init(M, D, G, bx);
        pg8::EpiUp E{(bf16*)(ws + WS_MIX), (const bf16*)(ws + WS_GA)};
        pg8::gemm_phase<pg8::EpiUp, pg8::StaticOrder, true, true>(lds, g, S, E);
    }
    grid.sync();

    {
        pg8::Gemm g{(const pg8::bf16_t*)(ws + WS_MIX), (const pg8::bf16_t*)(ws + WS_W_MIX), M, D, D}; pg8::StaticOrder S; S.init(M, D, G, bx);
        pg8::EpiRes E{out, (const float*)A.in[19], ALPHA};
        pg8::gemm_phase<pg8::EpiRes, pg8::StaticOrder, true, true>(lds, g, S, E);
    }
    grid.sync();
    for (int m = gw; m < M; m += NGW) ln_row(out + (size_t)m * D, (const float*)A.in[20], (const float*)A.in[21], out + (size_t)m * D, (bf16*)(ws + WS_H1B) + (size_t)m * D, lane);
    grid.sync();

    {
        pg8::Gemm g{(const pg8::bf16_t*)(ws + WS_H1B), (const pg8::bf16_t*)(ws + WS_W_XQ), M, D, D}; pg8::StaticOrder S; S.init(M, D, G, bx);
        pg8::EpiPlain<0> E{(bf16*)(ws + WS_QX), D, nullptr, 1.0f};
        pg8::gemm_phase<pg8::EpiPlain<0>, pg8::StaticOrder, true, true>(lds, g, S, E);
    }
    grid.sync();

    for (int u = bx; u < 512; u += G) xattn_unit(A, u / 128, (u / 32) % 4, u % 32, lds);
    grid.sync();

    {
        pg8::Gemm g{(const pg8::bf16_t*)(ws + WS_XO), (const pg8::bf16_t*)(ws + WS_W_XO), M, D, D}; pg8::StaticOrder S; S.init(M, D, G, bx);
        pg8::EpiRes E{out, nullptr, ALPHA};
        pg8::gemm_phase<pg8::EpiRes, pg8::StaticOrder, true, true>(lds, g, S, E);
    }
    grid.sync();
    for (int m = gw; m < M; m += NGW) ln_row(out + (size_t)m * D, (const float*)A.in[25], (const float*)A.in[26], out + (size_t)m * D, (bf16*)(ws + WS_H2B) + (size_t)m * D, lane);
    grid.sync();

    {
        pg8::Gemm g{(const pg8::bf16_t*)(ws + WS_H2B), (const pg8::bf16_t*)(ws + WS_W_FF1), M, FF, D}; pg8::StaticOrder S; S.init(M, FF, G, bx);
        pg8::EpiPlain<2> E{(bf16*)(ws + WS_FFH), FF, (const float*)A.in[28], 1.0f};
        pg8::gemm_phase<pg8::EpiPlain<2>, pg8::StaticOrder, true, true>(lds, g, S, E);
    }
    grid.sync();

    {
        pg8::Gemm g{(const pg8::bf16_t*)(ws + WS_FFH), (const pg8::bf16_t*)(ws + WS_W_FF2), M, D, FF}; pg8::StaticOrder S; S.init(M, D, G, bx);
        pg8::EpiRes E{out, (const float*)A.in[30], ALPHA};
        pg8::gemm_phase<pg8::EpiRes, pg8::StaticOrder, true, true>(lds, g, S, E);
    }
    grid.sync();
    for (int m = gw; m < M; m += NGW) ln_row(out + (size_t)m * D, (const float*)A.in[31], (const float*)A.in[32], out + (size_t)m * D, nullptr, lane);
}

extern "C" void kernel_launch(void* const* d_in, const int* in_sizes, int n_in, void* d_out, int out_size, void* d_ws, size_t ws_size, hipStream_t stream) {
    static int grid = 0;
    if (grid == 0) {
        int dev = 0, cus = 0, per_cu = 0;
        hipGetDevice(&dev);
        hipDeviceGetAttribute(&cus, hipDeviceAttributeMultiprocessorCount, dev);
        hipFuncSetAttribute((const void*)fwd_megakernel, hipFuncAttributeMaxDynamicSharedMemorySize, LDS_BYTES);
        hipOccupancyMaxActiveBlocksPerMultiprocessor(&per_cu, (const void*)fwd_megakernel, NT, LDS_BYTES);
        if (per_cu < 1) per_cu = 1;
        grid = cus * 1;
        (void)hipGetLastError();
        if (n_in != 33 || ws_size < 256 * MiB) { fprintf(stderr, "kernel_launch: unexpected n_in %d / ws %zu\n", n_in, ws_size); }
    }
    hipMemsetAsync((char*)d_ws + WS_CTL, 0, CTL_ZERO, stream);
    Args a{};
    for (int i = 0; i < 33; ++i) a.in[i] = d_in[i];
    a.out = (float*)d_out; a.ws = (unsigned char*)d_ws;
    void* args[] = {&a};
    hipError_t e = hipLaunchCooperativeKernel((const void*)fwd_megakernel, dim3(grid), dim3(NT), args, LDS_BYTES, stream);
    if (e != hipSuccess) fprintf(stderr, "cooperative launch failed: %s (grid %d)\n", hipGetErrorString(e), grid);
}
```

```cpp
#include <hip/hip_runtime.h>
#include <hip/hip_cooperative_groups.h>
#include <cstdio>
#include <cstdint>
namespace cg = cooperative_groups;
namespace pg8 {
#define PG8_LAS __attribute__((address_space(3)))
typedef unsigned short bf16_t;
typedef short bf16x8 __attribute__((ext_vector_type(8)));
typedef float f32x4 __attribute__((ext_vector_type(4)));
typedef unsigned u32x4 __attribute__((ext_vector_type(4)));
constexpr int BM = 256, BK = 64, HALF = 128, HTB = HALF * BK * 2  , STAGE_BYTES = 8 * HTB, NXCD = 8, WGM = 8;

__host__ __device__ __forceinline__ int lds_byte(int r, int c) { const int st = (r >> 4) * 2 + (c >> 5), rr = r & 15, cc = c & 31, ob = rr * 64 + cc * 2; return st * 1024 + (ob ^ (((ob >> 9) & 1) << 5)); }
__host__ __device__ __forceinline__ void stage_rc(int b, int& R, int& C) { const int st = b / 1024, sb = b % 1024, swz = sb ^ (((sb >> 9) & 1) << 5); R = (st >> 1) * 16 + swz / 64; C = (st & 1) * 32 + (swz % 64) / 2; }
__host__ __device__ __forceinline__ int perm32(int rho) { const int n = rho >> 4, i = rho & 15; return 8 * (i >> 2) + 4 * n + (i & 3); }

struct Unit { int pm, pn; };
struct Gemm { const bf16_t* A; const bf16_t* Bt; int M, N, K; };

struct StaticOrder {
    int nM, nN, nwg, G, c;
    __host__ __device__ void init(int M, int N, int G_, int c_) { nM = M / BM; nN = N / BM; nwg = nM * nN; G = G_; c = c_; }
    __host__ __device__ bool next(int i, Unit& u) const {
        const long L = (long)i * G + c; if (L >= nwg) return false;
        int wgid = (int)L; { const int q = nwg / NXCD, r = nwg % NXCD, xcd = wgid % NXCD, off = wgid / NXCD; wgid = (xcd < r ? xcd * (q + 1) : r * (q + 1) + (xcd - r) * q) + off; }
        const int nig = WGM * nN, gid = wgid / nig, fm = gid * WGM, gsz = (nM - fm) < WGM ? (nM - fm) : WGM;
        u.pm = fm + ((wgid % nig) % gsz); u.pn = (wgid % nig) / gsz; return true;
    }
    __device__ __forceinline__ void a_ready(const Unit&) const {}
    __device__ __forceinline__ void done(const Unit&) const {}
};

__device__ __forceinline__ unsigned cvt_pk_bf16(float lo, float hi) { unsigned r; asm volatile("v_cvt_pk_bf16_f32 %0, %1, %2" : "=v"(r) : "v"(lo), "v"(hi)); return r; }
typedef float f32x2 __attribute__((ext_vector_type(2)));
__device__ __forceinline__ float bf2f(unsigned short h) { return __uint_as_float(((unsigned)h) << 16); }
__device__ __forceinline__ float sigmoidf_(float x) { return __builtin_amdgcn_rcpf(1.0f + __builtin_amdgcn_exp2f(-1.4426950408889634f * x)); }
__device__ __forceinline__ u32x4 pack8(const f32x4 v0, const f32x4 v1) { u32x4 w; w.x = cvt_pk_bf16(v0[0], v0[1]); w.y = cvt_pk_bf16(v0[2], v0[3]); w.z = cvt_pk_bf16(v1[0], v1[1]); w.w = cvt_pk_bf16(v1[2], v1[3]); return w; }
__device__ __forceinline__ void unpack8(const u32x4 w, f32x4& v0, f32x4& v1) {
    v0[0] = __uint_as_float(w.x << 16); v0[1] = __uint_as_float(w.x & 0xffff0000u); v0[2] = __uint_as_float(w.y << 16); v0[3] = __uint_as_float(w.y & 0xffff0000u);
    v1[0] = __uint_as_float(w.z << 16); v1[1] = __uint_as_float(w.z & 0xffff0000u); v1[2] = __uint_as_float(w.w << 16); v1[3] = __uint_as_float(w.w & 0xffff0000u); }

template <int ACT> struct EpiPlain {
    static constexpr bool PERM = true, AFTER_DRAIN = false;
    bf16_t* O; int ldc; const float* bias; float scale;
    __device__ __forceinline__ void operator()(const f32x4 (&acc)[2][2][4][2], const Unit& u, int wr, int wc, int fr, int fq) const {
        const int row0 = u.pm * BM + wr * 64 + fr, col0 = u.pn * BM + wc * 32 + 8 * fq;
#pragma unroll
        for (int bj = 0; bj < 2; ++bj) {
            f32x4 b0 = (f32x4){0.f, 0.f, 0.f, 0.f}, b1 = b0;
            if (bias) { b0 = *(const f32x4*)(bias + col0 + bj * HALF); b1 = *(const f32x4*)(bias + col0 + bj * HALF + 4); }
#pragma unroll
            for (int ai = 0; ai < 2; ++ai)
#pragma unroll
                for (int m = 0; m < 4; ++m) {
                    f32x4 v0 = acc[ai][bj][m][0] + b0, v1 = acc[ai][bj][m][1] + b1;
                    if (ACT == 2) {
#pragma unroll
                        for (int e = 0; e < 4; ++e) { float a = fmaxf(v0[e], 0.f); v0[e] = a * a; float c = fmaxf(v1[e], 0.f); v1[e] = c * c; } }
                    v0 = v0 * scale; v1 = v1 * scale;
                    *(u32x4*)(O + (size_t)(row0 + ai * HALF + m * 16) * ldc + col0 + bj * HALF) = pack8(v0, v1);
                }
        }
    }
};

struct EpiProj {
    static constexpr bool PERM = true, AFTER_DRAIN = false;
    bf16_t *U, *Q, *K, *V, *GS, *GA; const float* bias; const float* rope;
    __device__ __forceinline__ void operator()(const f32x4 (&acc)[2][2][4][2], const Unit& u, int wr, int wc, int fr, int fq) const {
        const int row0 = u.pm * BM + wr * 64 + fr, colg = u.pn * BM + wc * 32 + 8 * fq;
        bf16_t* base; int ldc, coll; bool rot = false;
        const int pn = u.pn;
        if (pn < 3) { base = U; ldc = 768; coll = colg; }
        else if (pn < 6) { base = Q; ldc = 768; coll = colg - 768; rot = true; }
        else if (pn < 9) { base = K; ldc = 768; coll = colg - 1536; rot = true; }
        else if (pn < 12) { base = V; ldc = 768; coll = colg - 2304; }
        else if (pn < 16) { base = GS; ldc = 1024; coll = colg - 3072; }
        else { base = GA; ldc = 1024; coll = colg - 4096; }
        const bool rl = rot && ((wc & 1) == 0);
#pragma unroll
        for (int bj = 0; bj < 2; ++bj) {
            const f32x4 b0 = *(const f32x4*)(bias + colg + bj * HALF), b1 = *(const f32x4*)(bias + colg + bj * HALF + 4);
#pragma unroll
            for (int ai = 0; ai < 2; ++ai)
#pragma unroll
                for (int m = 0; m < 4; ++m) {
                    const int row = row0 + ai * HALF + m * 16;
                    f32x4 v0 = acc[ai][bj][m][0] + b0, v1 = acc[ai][bj][m][1] + b1;
                    if (rl) {
                        f32x4 p0, p1;
#pragma unroll
                        for (int e = 0; e < 4; ++e) { p0[e] = __shfl_xor(v0[e], 16); p1[e] = __shfl_xor(v1[e], 16); }
                        if (fq < 2) {
                            const f32x4 c0 = *(const f32x4*)(rope + (size_t)row * 16), c1 = *(const f32x4*)(rope + (size_t)row * 16 + 4);
                            const f32x4 s0 = *(const f32x4*)(rope + (size_t)row * 16 + 8), s1 = *(const f32x4*)(rope + (size_t)row * 16 + 12);
                            if (fq == 0) { v0 = v0 * c0 - p0 * s0; v1 = v1 * c1 - p1 * s1; }
                            else         { v0 = v0 * c0 + p0 * s0; v1 = v1 * c1 + p1 * s1; }
                        }
                    }
                    *(u32x4*)(base + (size_t)row * ldc + coll + bj * HALF) = pack8(v0, v1);
                    asm volatile("" ::: "memory");
                }
        }
    }
};

struct EpiXkv {
    static constexpr bool PERM = true, AFTER_DRAIN = false;
    bf16_t *Kx, *Vxt;
    __device__ __forceinline__ void operator()(const f32x4 (&acc)[2][2][4][2], const Unit& u, int wr, int wc, int fr, int fq) const {
        const int row0 = u.pm * BM + wr * 64 + fr; const int pn = u.pn;
#pragma unroll
        for (int bj = 0; bj < 2; ++bj)
#pragma unroll
            for (int ai = 0; ai < 2; ++ai)
#pragma unroll
                for (int m = 0; m < 4; ++m) {
                    const int row = row0 + ai * HALF + m * 16, b = row >> 8, key = row & 255;
                    const int d0 = bj * HALF + wc * 32 + 8 * fq;
                    const u32x4 w = pack8(acc[ai][bj][m][0], acc[ai][bj][m][1]);
                    if (pn < 4) { *(u32x4*)(Kx + ((size_t)(b * 4 + pn) * 256 + key) * 256 + d0) = w; }
                    else { bf16_t* vp = Vxt + ((size_t)(b * 4 + (pn - 4)) * 256 + d0) * 256 + key;
                        vp[0] = (bf16_t)(w.x & 0xffffu); vp[256] = (bf16_t)(w.x >> 16); vp[512] = (bf16_t)(w.y & 0xffffu); vp[768] = (bf16_t)(w.y >> 16);
                        vp[1024] = (bf16_t)(w.z & 0xffffu); vp[1280] = (bf16_t)(w.z >> 16); vp[1536] = (bf16_t)(w.w & 0xffffu); vp[1792] = (bf16_t)(w.w >> 16); }
                }
    }
};

struct EpiGlu {
    static constexpr bool PERM = true, AFTER_DRAIN = false;
    bf16_t* MIX; const bf16_t* GS; const float* bias;
    __device__ __forceinline__ void operator()(const f32x4 (&acc)[2][2][4][2], const Unit& u, int wr, int wc, int fr, int fq) const {
        const int row0 = u.pm * BM + wr * 64 + fr, col = u.pn * HALF + wc * 32 + 8 * fq;
        const f32x4 bv0 = *(const f32x4*)(bias + col), bv1 = *(const f32x4*)(bias + col + 4), bg0 = *(const f32x4*)(bias + 1024 + col), bg1 = *(const f32x4*)(bias + 1024 + col + 4);
#pragma unroll
        for (int ai = 0; ai < 2; ++ai)
#pragma unroll
            for (int m = 0; m < 4; ++m) {
                const size_t off = (size_t)(row0 + ai * HALF + m * 16) * 1024 + col;
                f32x4 g0, g1; unpack8(*(const u32x4*)(GS + off), g0, g1);
                const f32x4 a0 = acc[ai][0][m][0] + bv0, a1 = acc[ai][0][m][1] + bv1, t0 = acc[ai][1][m][0] + bg0, t1 = acc[ai][1][m][1] + bg1;
                f32x4 o0, o1;
#pragma unroll
                for (int e = 0; e < 4; ++e) { o0[e] = sigmoidf_(g0[e]) * a0[e] * sigmoidf_(t0[e]); o1[e] = sigmoidf_(g1[e]) * a1[e] * sigmoidf_(t1[e]); }
                *(u32x4*)(MIX + off) = pack8(o0, o1);
                asm volatile("" ::: "memory");
            }
    }
};

typedef unsigned u32x2_ __attribute__((ext_vector_type(2)));
struct EpiUp {
    static constexpr bool PERM = true, AFTER_DRAIN = false;
    bf16_t* MIX; const bf16_t* GA;
    __device__ __forceinline__ void operator()(const f32x4 (&acc)[2][2][4][2], const Unit& u, int wr, int wc, int fr, int fq) const {
        const int row0 = u.pm * BM + wr * 64 + fr, col0 = u.pn * BM + wc * 32 + 8 * fq;
#pragma unroll
        for (int bj = 0; bj < 2; ++bj)
#pragma unroll
            for (int ai = 0; ai < 2; ++ai)
#pragma unroll
                for (int m = 0; m < 4; ++m)
#pragma unroll
                    for (int n = 0; n < 2; ++n) {
                        const size_t off = (size_t)(row0 + ai * HALF + m * 16) * 1024 + col0 + bj * HALF + 4 * n;
                        const u32x2_ g = *(const u32x2_*)(GA + off), x = *(const u32x2_*)(MIX + off);
                        const f32x4 a = acc[ai][bj][m][n];
                        const float r0 = __uint_as_float(x.x << 16) + sigmoidf_(__uint_as_float(g.x << 16)) * a[0];
                        const float r1 = __uint_as_float(x.x & 0xffff0000u) + sigmoidf_(__uint_as_float(g.x & 0xffff0000u)) * a[1];
                        const float r2 = __uint_as_float(x.y << 16) + sigmoidf_(__uint_as_float(g.y << 16)) * a[2];
                        const float r3 = __uint_as_float(x.y & 0xffff0000u) + sigmoidf_(__uint_as_float(g.y & 0xffff0000u)) * a[3];
                        u32x2_ o; o.x = cvt_pk_bf16(r0, r1); o.y = cvt_pk_bf16(r2, r3);
                        *(u32x2_*)(MIX + off) = o;
                        asm volatile("" ::: "memory");
                    }
    }
};

struct EpiRes {
    static constexpr bool PERM = true, AFTER_DRAIN = false;
    float* R; const float* bias; float alpha;
    __device__ __forceinline__ void operator()(const f32x4 (&acc)[2][2][4][2], const Unit& u, int wr, int wc, int fr, int fq) const {
        const int row0 = u.pm * BM + wr * 64 + fr, col0 = u.pn * BM + wc * 32 + 8 * fq;
#pragma unroll
        for (int bj = 0; bj < 2; ++bj) {
            f32x4 b0 = (f32x4){0.f, 0.f, 0.f, 0.f}, b1 = b0;
            if (bias) { b0 = *(const f32x4*)(bias + col0 + bj * HALF); b1 = *(const f32x4*)(bias + col0 + bj * HALF + 4); }
#pragma unroll
            for (int ai = 0; ai < 2; ++ai)
#pragma unroll
                for (int m = 0; m < 4; ++m) {
                    float* p = R + (size_t)(row0 + ai * HALF + m * 16) * 1024 + col0 + bj * HALF;
                    const f32x4 r0 = *(const f32x4*)p, r1 = *(const f32x4*)(p + 4);
                    *(f32x4*)p = r0 * alpha + acc[ai][bj][m][0] + b0; *(f32x4*)(p + 4) = r1 * alpha + acc[ai][bj][m][1] + b1;
                    asm volatile("" ::: "memory");
                }
        }
    }
};
template <class Epi, class Sched, bool ALIGN_EPI = false, bool SP2 = false>
__device__ __forceinline__ void gemm_phase(PG8_LAS unsigned char* lds, const Gemm g, const Sched& S, const Epi& E) {
    const int tid = threadIdx.x, wid = __builtin_amdgcn_readfirstlane(tid >> 6), lane = tid & 63, wr = wid >> 2, wc = wid & 3, fr = lane & 15, fq = lane >> 4;
    const int K = g.K, nt = K / BK;
    unsigned voffA[2], voffB[2];
#pragma unroll
    for (int i = 0; i < 2; ++i) { int R, C; stage_rc(tid * 16 + i * 8192, R, C); const int Rb = Epi::PERM ? ((R & ~31) + perm32(R & 31)) : R;
        voffA[i] = (unsigned)(R * K + C) * 2u; voffB[i] = (unsigned)(Rb * K + C) * 2u; }
    const size_t kstep = (size_t)(BK * 2);
    const size_t hstep = (size_t)HALF * K * 2;
    const size_t tstep = 2 * hstep;
    const unsigned ldsw = (unsigned)wid * 1024u;
    const int aoff = lds_byte(wr * 64 + fr, fq * 8), boff = lds_byte(wc * 32 + fr, fq * 8);
#define PG8_SA(b, h) (((b) * 2 + (h)) * HTB)
#define PG8_SB(b, h) ((4 + (b) * 2 + (h)) * HTB)
#define PG8_STAGE(bufoff, gbase, voff) do { _Pragma("unroll") for (int _i = 0; _i < 2; ++_i) \
        __builtin_amdgcn_global_load_lds((const unsigned*)((const char*)(gbase) + (voff)[_i]), (PG8_LAS unsigned*)(lds + (bufoff) + ldsw + _i * 8192), 16, 0, 0); } while (0)
#define PG8_LDA(dst, b, h) do { _Pragma("unroll") for (int m = 0; m < 4; ++m) _Pragma("unroll") for (int k = 0; k < 2; ++k) dst[m][k] = *(const PG8_LAS bf16x8*)(lds + PG8_SA(b, h) + aoff + m * 2048 + k * 1024); } while (0)
#define PG8_LDB(dst, b, h) do { _Pragma("unroll") for (int n = 0; n < 2; ++n) _Pragma("unroll") for (int k = 0; k < 2; ++k) dst[n][k] = *(const PG8_LAS bf16x8*)(lds + PG8_SB(b, h) + boff + n * 2048 + k * 1024); } while (0)
#define PG8_MMA(ai, bj, At, Bt) do { __builtin_amdgcn_s_setprio(1); _Pragma("unroll") for (int m = 0; m < 4; ++m) _Pragma("unroll") for (int n = 0; n < 2; ++n) _Pragma("unroll") for (int k = 0; k < 2; ++k) \
        acc[ai][bj][m][n] = __builtin_amdgcn_mfma_f32_16x16x32_bf16(Bt[n][k], At[m][k], acc[ai][bj][m][n], 0, 0, 0); __builtin_amdgcn_s_setprio(0); } while (0)
#define PG8_WAIT_V(n) asm volatile("s_waitcnt vmcnt(" #n ")" ::: "memory")
#define PG8_WAIT_L(n) asm volatile("s_waitcnt lgkmcnt(" #n ")" ::: "memory")
#define PG8_BAR __builtin_amdgcn_s_barrier()
#define PG8_SCHED __builtin_amdgcn_sched_barrier(0)
    Unit cur, nxt; int ui = 0;
    if (!S.next(0, cur)) return;
    f32x4 acc[2][2][4][2];
#pragma unroll
    for (int a = 0; a < 2; ++a)
#pragma unroll
        for (int b = 0; b < 2; ++b)
#pragma unroll
            for (int m = 0; m < 4; ++m)
#pragma unroll
                for (int n = 0; n < 2; ++n) acc[a][b][m][n] = (f32x4){0.f, 0.f, 0.f, 0.f};
    bf16x8 At[4][2], B0[2][2], B1[2][2];
    const char* cA = (const char*)g.A + (size_t)cur.pm * tstep; const char* cB = (const char*)g.Bt + (size_t)cur.pn * tstep;
    S.a_ready(cur);
    if constexpr (SP2) {
        PG8_STAGE(PG8_SB(0, 0), cB, voffB); PG8_STAGE(PG8_SB(0, 1), cB + hstep, voffB); PG8_STAGE(PG8_SA(0, 0), cA, voffA); PG8_STAGE(PG8_SA(0, 1), cA + hstep, voffA);
        if (wr == 1) PG8_BAR;
        PG8_WAIT_V(2); PG8_BAR;
        PG8_STAGE(PG8_SB(1, 0), cB + kstep, voffB); PG8_STAGE(PG8_SA(1, 0), cA + kstep, voffA); PG8_STAGE(PG8_SB(1, 1), cB + hstep + kstep, voffB);
        PG8_WAIT_V(6); PG8_BAR;
    } else {
        PG8_STAGE(PG8_SB(0, 0), cB, voffB); PG8_STAGE(PG8_SA(0, 0), cA, voffA); PG8_STAGE(PG8_SB(0, 1), cB + hstep, voffB); PG8_STAGE(PG8_SA(0, 1), cA + hstep, voffA);
        if (wr == 1) PG8_BAR;
        PG8_WAIT_V(4); PG8_BAR;
        PG8_STAGE(PG8_SB(1, 0), cB + kstep, voffB); PG8_STAGE(PG8_SA(1, 0), cA + kstep, voffA); PG8_STAGE(PG8_SB(1, 1), cB + hstep + kstep, voffB);
        PG8_WAIT_V(6); PG8_BAR;
    }
    for (;;) {
        const bool has_next = S.next(ui + 1, nxt);
        const char* nA = has_next ? (const char*)g.A + (size_t)nxt.pm * tstep : cA; const char* nB = has_next ? (const char*)g.Bt + (size_t)nxt.pn * tstep : cB;
        for (int t = 0; t < nt; t += 2) {
            const bool last = (t == nt - 2);
            const char* a1 = cA + (size_t)(t + 1) * kstep;
            const char* a2 = last ? nA : cA + (size_t)(t + 2) * kstep; const char* b2 = last ? nB : cB + (size_t)(t + 2) * kstep;
            const char* a3 = a2 + kstep; const char* b3 = b2 + kstep;
            if (last && has_next) S.a_ready(nxt);
            if constexpr (SP2) {
            PG8_LDB(B0, 0, 0); PG8_LDB(B1, 0, 1); PG8_SCHED; PG8_LDA(At, 0, 0); PG8_STAGE(PG8_SA(1, 1), a1 + hstep, voffA);
            PG8_WAIT_V(8); PG8_WAIT_L(0); PG8_BAR; PG8_MMA(0, 0, At, B0); PG8_MMA(0, 1, At, B1); PG8_BAR; PG8_SCHED;
            PG8_LDA(At, 0, 1); PG8_STAGE(PG8_SB(0, 0), b2, voffB); PG8_STAGE(PG8_SB(0, 1), b2 + hstep, voffB); PG8_STAGE(PG8_SA(0, 0), a2, voffA);
            PG8_WAIT_V(8); PG8_WAIT_L(0); PG8_BAR; PG8_MMA(1, 0, At, B0); PG8_MMA(1, 1, At, B1); PG8_BAR; PG8_SCHED;
            PG8_LDB(B0, 1, 0); PG8_LDB(B1, 1, 1); PG8_SCHED; PG8_LDA(At, 1, 0); PG8_STAGE(PG8_SA(0, 1), a2 + hstep, voffA);
            PG8_WAIT_V(8); PG8_WAIT_L(0); PG8_BAR; PG8_MMA(0, 0, At, B0); PG8_MMA(0, 1, At, B1); PG8_BAR; PG8_SCHED;
            PG8_LDA(At, 1, 1); PG8_STAGE(PG8_SB(1, 0), b3, voffB); PG8_STAGE(PG8_SB(1, 1), b3 + hstep, voffB); PG8_STAGE(PG8_SA(1, 0), a3, voffA);
            PG8_WAIT_V(8); PG8_WAIT_L(0); PG8_BAR; PG8_MMA(1, 0, At, B0); PG8_MMA(1, 1, At, B1); PG8_BAR; PG8_SCHED;
            } else {
            PG8_LDB(B0, 0, 0); PG8_SCHED; PG8_LDA(At, 0, 0); PG8_STAGE(PG8_SA(1, 1), a1 + hstep, voffA);
            PG8_WAIT_L(8); PG8_BAR; PG8_WAIT_L(0); PG8_MMA(0, 0, At, B0); PG8_BAR; PG8_SCHED;
            PG8_LDB(B1, 0, 1); PG8_STAGE(PG8_SB(0, 0), b2, voffB);
            PG8_BAR; PG8_WAIT_L(0); PG8_MMA(0, 1, At, B1); PG8_BAR;
            PG8_LDA(At, 0, 1); PG8_STAGE(PG8_SA(0, 0), a2, voffA);
            PG8_BAR; PG8_WAIT_L(0); PG8_MMA(1, 0, At, B0); PG8_BAR; PG8_SCHED;
            PG8_STAGE(PG8_SB(0, 1), b2 + hstep, voffB);
            PG8_WAIT_V(6); PG8_BAR; PG8_MMA(1, 1, At, B1); PG8_BAR;
            PG8_LDB(B0, 1, 0); PG8_SCHED; PG8_LDA(At, 1, 0); PG8_STAGE(PG8_SA(0, 1), a2 + hstep, voffA);
            PG8_WAIT_L(8); PG8_BAR; PG8_WAIT_L(0); PG8_MMA(0, 0, At, B0); PG8_BAR; PG8_SCHED;
            PG8_LDB(B1, 1, 1); PG8_STAGE(PG8_SB(1, 0), b3, voffB);
            PG8_BAR; PG8_WAIT_L(0); PG8_MMA(0, 1, At, B1); PG8_BAR;
            PG8_LDA(At, 1, 1); PG8_STAGE(PG8_SA(1, 0), a3, voffA);
            PG8_BAR; PG8_WAIT_L(0); PG8_MMA(1, 0, At, B0); PG8_BAR; PG8_SCHED;
            PG8_STAGE(PG8_SB(1, 1), b3 + hstep, voffB);
            PG8_WAIT_V(6); PG8_BAR; PG8_MMA(1, 1, At, B1); PG8_BAR;
            }
        }
        if constexpr (ALIGN_EPI) { if (wr == 0) PG8_BAR; }
        if constexpr (!Epi::AFTER_DRAIN) { E(acc, cur, wr, wc, fr, fq); S.done(cur); }
        if (!has_next) break;
#pragma unroll
        for (int a = 0; a < 2; ++a)
#pragma unroll
            for (int b = 0; b < 2; ++b)
#pragma unroll
                for (int m = 0; m < 4; ++m)
#pragma unroll
                    for (int n = 0; n < 2; ++n) acc[a][b][m][n] = (f32x4){0.f, 0.f, 0.f, 0.f};
        cur = nxt; cA = nA; cB = nB; ++ui;
        if constexpr (ALIGN_EPI) { if (wr == 1) PG8_BAR; }
    }
    PG8_WAIT_V(0);
    if constexpr (!ALIGN_EPI) { if (wr == 0) PG8_BAR; }
    PG8_BAR;
    if constexpr (Epi::AFTER_DRAIN) { E.fused(acc, cur, wr, wc, fr, fq, lds, wid, lane); S.done(cur); }
#undef PG8_SA
#undef PG8_SB
#undef PG8_STAGE
#undef PG8_LDA
#undef PG8_LDB
#undef PG8_MMA
#undef PG8_WAIT_V
#undef PG8_WAIT_L
#undef PG8_BAR
#undef PG8_SCHED
}
}
#define LAS __attribute__((address_space(3)))
typedef unsigned short bf16;
typedef short bf16x8 __attribute__((ext_vector_type(8)));
typedef short s16x4 __attribute__((ext_vector_type(4)));
typedef float f32x4 __attribute__((ext_vector_type(4)));
typedef float f32x2 __attribute__((ext_vector_type(2)));
typedef unsigned u32x4 __attribute__((ext_vector_type(4)));
typedef unsigned u32x2 __attribute__((ext_vector_type(2)));

constexpr int NW = 8, NT = 512;
constexpr int M = 16384, D = 1024, SEQ = 4096, NB = 4, FF = 4096, INC = 5120;
constexpr float LN_EPS = 1e-5f;
constexpr float ALPHA = 1.189207115002721f;
constexpr float LOG2E = 1.4426950408889634f, LN2 = 0.6931471805599453f;
constexpr size_t MiB = 1u << 20;
constexpr size_t WS_CTL = 0, CTL_ZERO = 65536, BAR_WORD0 = 1024, WS_LSE = 128 * 1024;
constexpr size_t WS_W_IN = 1 * MiB, WS_W_GLU = 11 * MiB, WS_W_UP = 14 * MiB, WS_W_MIX = 15 * MiB, WS_W_XQ = 17 * MiB, WS_W_XKV = 19 * MiB, WS_W_XO = 23 * MiB,
                 WS_W_FF1 = 25 * MiB, WS_W_FF2 = 33 * MiB, WS_ROPE = 41 * MiB, WS_MEMB = 42 * MiB, WS_KX = 44 * MiB, WS_VXT = 46 * MiB;
constexpr size_t WS_H0B = 48 * MiB;
constexpr size_t WS_YS = 48 * MiB, WS_OG0 = 72 * MiB, WS_H2B = 48 * MiB;
constexpr size_t WS_U = 80 * MiB, WS_Q = 104 * MiB, WS_K = 128 * MiB, WS_V = 152 * MiB, WS_GS = 176 * MiB, WS_GA = 208 * MiB, WS_OG1 = 240 * MiB, WS_OG2 = 248 * MiB;
constexpr size_t WS_MIX = 80 * MiB, WS_ATT = 112 * MiB, WS_H1B = 128 * MiB, WS_QX = 160 * MiB, WS_XO = 192 * MiB, WS_FFH = 80 * MiB;
constexpr int LDS_BYTES = 147456;

__device__ __forceinline__ unsigned pk2(float lo, float hi) { return pg8::cvt_pk_bf16(lo, hi); }
__device__ __forceinline__ float bf2f(unsigned short h) { return __uint_as_float(((unsigned)h) << 16); }
__device__ __forceinline__ float wave_sum(float v) {
#pragma unroll
    for (int o = 1; o < 64; o <<= 1) v += __shfl_xor(v, o);
    return v;
}
#define LDS_WAIT() asm volatile("s_waitcnt lgkmcnt(0)" ::: "memory")

struct Args { const void* in[33]; float* out; unsigned char* ws; };
#define XB_TMO      128
#define XB_XCNT(j)  (256  + 64 * (j))
#define XB_XSUB(j)  (1280 + 64 * (j))
#define XB_XGEN(j)  (2304 + 64 * (j))
#define XB_TOP      3328
#define XB_TOPGEN   3392
#define XCD_BAR_WORDS 3456
#define XB_SPIN_CAP (1u << 18)

__device__ __forceinline__ unsigned xb_ld(unsigned* p)              { return __hip_atomic_load(p, __ATOMIC_RELAXED, __HIP_MEMORY_SCOPE_AGENT); }
__device__ __forceinline__ unsigned xb_add(unsigned* p, unsigned v) { return __hip_atomic_fetch_add(p, v, __ATOMIC_RELAXED, __HIP_MEMORY_SCOPE_AGENT); }
__device__ __forceinline__ unsigned xb_xcc_id() { return (unsigned)__builtin_amdgcn_s_getreg((3 << 11) | 20) & 0xFu; }
#define XB_SPIN(cond, bar) do { unsigned _sp = 0; while (cond) { __builtin_amdgcn_s_sleep(1); \
    if ((++_sp & 255u) == 0u) { if (xb_ld(&(bar)[XB_TMO])) break; if (_sp > XB_SPIN_CAP) { atomicAdd(&(bar)[XB_TMO], 1u); break; } } } } while (0)

struct XcdBarrier {
    unsigned* bar; unsigned x;
    volatile LAS unsigned* st;
};

__device__ __forceinline__ XcdBarrier xcd_barrier_post(unsigned* bar, volatile LAS unsigned* st) {
    XcdBarrier b; b.bar = bar; b.x = xb_xcc_id(); b.st = st;
    if (threadIdx.x == 0) (void)xb_add(&bar[XB_XCNT(b.x)], 1u);
    return b;
}
__device__ __forceinline__ void xcd_barrier_complete(unsigned* bar, unsigned x, unsigned& nloc, unsigned& nx) {
    const unsigned G = gridDim.x * gridDim.y * gridDim.z;
    unsigned sum, cnt, mine, sp = 0u;
    for (;;) {
        sum = 0u; cnt = 0u; mine = 0u;
#pragma unroll
        for (unsigned j = 0; j < 16; ++j) { const unsigned c = xb_ld(&bar[XB_XCNT(j)]); sum += c; cnt += (c > 0u) ? 1u : 0u; mine = (j == x) ? c : mine; }
        if (sum == G) break;
        __builtin_amdgcn_s_sleep(1);
        if ((++sp & 255u) == 0u) { if (xb_ld(&bar[XB_TMO])) break; if (sp > XB_SPIN_CAP) { atomicAdd(&bar[XB_TMO], 1u); break; } }
    }
    nloc = mine > 0u ? mine : 1u; nx = cnt > 0u ? cnt : 1u;
}

__device__ __forceinline__ void xcd_barrier(const XcdBarrier& b) {
    asm volatile("s_waitcnt vmcnt(0)" ::: "memory");
    __syncthreads();
    if (threadIdx.x == 0) {
        unsigned* bar = b.bar;
        __builtin_amdgcn_s_waitcnt(0);
        unsigned nloc = b.st[0], nx = b.st[1];
        if (nloc == 0u) { xcd_barrier_complete(bar, b.x, nloc, nx); b.st[0] = nloc; b.st[1] = nx; }
        const unsigned old = xb_add(&bar[XB_XSUB(b.x)], 1u);
        const unsigned gen = old / nloc;
        if (old + 1u == (gen + 1u) * nloc) {
            __builtin_amdgcn_fence(__ATOMIC_RELEASE, "agent");
            asm volatile("s_waitcnt vmcnt(0)" ::: "memory");
            const unsigned og = xb_add(&bar[XB_TOP], 1u);
            const unsigned tg = og / nx;
            if (og + 1u == (tg + 1u) * nx) xb_add(&bar[XB_TOPGEN], 1u);
            else XB_SPIN(xb_ld(&bar[XB_TOPGEN]) == tg, bar);
            __builtin_amdgcn_fence(__ATOMIC_ACQUIRE, "agent");
            xb_add(&bar[XB_XGEN(b.x)], 1u);
            asm volatile("s_waitcnt vmcnt(0)" ::: "memory");
        } else {
            XB_SPIN(xb_ld(&bar[XB_XGEN(b.x)]) == gen, bar);
            __builtin_amdgcn_fence(__ATOMIC_ACQUIRE, "agent");
            asm volatile("s_waitcnt vmcnt(0)" ::: "memory");
        }
    }
    __syncthreads();
}


__device__ __forceinline__ void p0_transpose_item(const float* W, int K, int N, bf16* WT, int k0, int n0, int drow0, LAS float* scr, int lane) {
#pragma unroll 8
    for (int i = 0; i < 32; ++i) { const int kk = 2 * i + (lane >> 5); scr[kk * 33 + (lane & 31)] = W[(size_t)(k0 + kk) * N + n0 + (lane & 31)]; }
    LDS_WAIT();
    const int c = lane & 7;
#pragma unroll
    for (int j = 0; j < 4; ++j) { const int n = (lane >> 3) + 8 * j; const LAS float* s = scr + (8 * c) * 33 + n;
        u32x4 o; o.x = pk2(s[0 * 33], s[1 * 33]); o.y = pk2(s[2 * 33], s[3 * 33]); o.z = pk2(s[4 * 33], s[5 * 33]); o.w = pk2(s[6 * 33], s[7 * 33]);
        *(u32x4*)(WT + (size_t)(drow0 + n) * K + k0 + 8 * c) = o; }
    LDS_WAIT();
}
__device__ __forceinline__ void p0_matrix(const float* W, int K, int N, bf16* WT, bool glu, LAS float* scr, int lane, int it) {
    const int nblk = N / 32, kb = it / nblk, nb = it % nblk, n0 = 32 * nb;
    int drow0 = n0;
    if (glu) { const int half = n0 >> 10, c = n0 & 1023; drow0 = (c >> 7) * 256 + half * 128 + (c & 127); }
    p0_transpose_item(W, K, N, WT, 64 * kb, n0, drow0, scr, lane);
}
__device__ __forceinline__ void ln_row(const float* xrow, const float* g, const float* b, float* of, bf16* ob, int lane) {
    const f32x4* xr = (const f32x4*)xrow + lane;
    f32x4 v[4]; float s = 0.f;
#pragma unroll
    for (int j = 0; j < 4; ++j) { v[j] = xr[64 * j]; s += (v[j].x + v[j].y) + (v[j].z + v[j].w); }
    const float mean = wave_sum(s) * (1.f / D); float s2 = 0.f;
#pragma unroll
    for (int j = 0; j < 4; ++j) { v[j] = v[j] - mean; s2 += (v[j].x * v[j].x + v[j].y * v[j].y) + (v[j].z * v[j].z + v[j].w * v[j].w); }
    const float rstd = 1.f / sqrtf(wave_sum(s2) * (1.f / D) + LN_EPS);
#pragma unroll
    for (int j = 0; j < 4; ++j) {
        const f32x4 gg = ((const f32x4*)g)[lane + 64 * j], bb = ((const f32x4*)b)[lane + 64 * j];
        const f32x4 y = v[j] * rstd * gg + bb;
        if (of) ((f32x4*)of)[lane + 64 * j] = y;
        if (ob) { u32x2 w; w.x = pk2(y.x, y.y); w.y = pk2(y.z, y.w); ((u32x2*)ob)[lane + 64 * j] = w; }
    }
}

__device__ __forceinline__ float gelu_tanh(float x) { const float z = 0.7978845608028654f * (x + 0.044715f * x * x * x); return x / (1.0f + __expf(-2.0f * z)); }

__device__ __forceinline__ void ssm_unit(const Args& A, int b, int g, LAS unsigned char* lds) {
    const int tid = threadIdx.x, lane = tid & 63, w = __builtin_amdgcn_readfirstlane(tid >> 6), fr = lane & 15, fq = lane >> 4;
    const float* log_dt = (const float*)A.in[7]; const float* a_re = (const float*)A.in[8]; const float* a_im = (const float*)A.in[9];
    const float* b_re = (const float*)A.in[10]; const float* b_im = (const float*)A.in[11]; const float* c_re = (const float*)A.in[12]; const float* c_im = (const float*)A.in[13];
    const float* dsk = (const float*)A.in[14];
    const bf16* U = (const bf16*)(A.ws + WS_U); bf16* YS = (bf16*)(A.ws + WS_YS);
    LAS float* Wl = (LAS float*)(lds + w * 12800);
    LAS bf16* Hl = (LAS bf16*)(lds + w * 12800 + 8448);
    LAS float* Cl = (LAS float*)(lds + 8 * 12800);
    const float dt = __expf(log_dt[g]);
    float lr, li;
    { const float are = a_re[g * 64 + lane], aim = a_im[g * 64 + lane]; const float mag = __expf(are * dt); lr = mag * cosf(aim * dt); li = mag * sinf(aim * dt); }
    s16x4 abr[4], abi[4];
#pragma unroll
    for (int nb = 0; nb < 4; ++nb) {
        const int n = 16 * nb + fr; const float are = a_re[g * 64 + n], aim = a_im[g * 64 + n];
        const float mag = __expf(are * dt), xr = mag * cosf(aim * dt), xi = mag * sinf(aim * dt), den = are * are + aim * aim, nr = xr - 1.0f;
        const float fre = (nr * are + xi * aim) / den, fim = (xi * are - nr * aim) / den;
        const f32x4 br = *(const f32x4*)(b_re + ((size_t)g * 64 + n) * 16 + 4 * fq), bi = *(const f32x4*)(b_im + ((size_t)g * 64 + n) * 16 + 4 * fq);
        const f32x4 bbr = br * fre - bi * fim, bbi = bi * fre + br * fim;
        u32x2 t; t.x = pk2(bbr[0], bbr[1]); t.y = pk2(bbr[2], bbr[3]); abr[nb] = __builtin_bit_cast(s16x4, t);
        t.x = pk2(bbi[0], bbi[1]); t.y = pk2(bbi[2], bbi[3]); abi[nb] = __builtin_bit_cast(s16x4, t);
    }
    bf16x8 cf[4];
#pragma unroll
    for (int kb = 0; kb < 4; ++kb) {
        const float* src = (kb < 2 ? c_re : c_im) + ((size_t)g * 16 + fr) * 64 + (kb & 1) * 32 + 8 * fq;
        f32x4 x0 = *(const f32x4*)src, x1 = *(const f32x4*)(src + 4);
        if (kb >= 2) { x0 = -x0; x1 = -x1; }
        cf[kb] = __builtin_bit_cast(bf16x8, pg8::pack8(x0, x1));
    }
    const f32x4 dv = *(const f32x4*)(dsk + 16 * g + 4 * fq);
    const size_t rowbase = (size_t)b * SEQ + (size_t)w * 512;
    float hr = 0.f, hi = 0.f;
    for (int tile = 0; tile < 32; ++tile) {
        const s16x4 uf = *(const s16x4*)(U + (rowbase + tile * 16 + fr) * 768 + 16 * g + 4 * fq);
#pragma unroll
        for (int nb = 0; nb < 4; ++nb) {
            const f32x4 z = (f32x4){0.f, 0.f, 0.f, 0.f};
            const f32x4 wre = __builtin_amdgcn_mfma_f32_16x16x16bf16_1k(abr[nb], uf, z, 0, 0, 0);
            const f32x4 wim = __builtin_amdgcn_mfma_f32_16x16x16bf16_1k(abi[nb], uf, z, 0, 0, 0);
            *(LAS f32x4*)(Wl + fr * 132 + 16 * nb + 4 * fq) = wre; *(LAS f32x4*)(Wl + fr * 132 + 64 + 16 * nb + 4 * fq) = wim;
        }
        LDS_WAIT();
#pragma unroll
        for (int t = 0; t < 16; ++t) { const float wr_ = Wl[t * 132 + lane], wi_ = Wl[t * 132 + 64 + lane];
            const float nr = lr * hr - li * hi + wr_, ni = lr * hi + li * hr + wi_; hr = nr; hi = ni; }
        LDS_WAIT();
    }
    Cl[w * 128 + lane] = hr; Cl[w * 128 + 64 + lane] = hi;
    float pr = lr, pi = li;
#pragma unroll
    for (int i = 0; i < 9; ++i) { const float nr = pr * pr - pi * pi, ni = 2.0f * pr * pi; pr = nr; pi = ni; }
    __syncthreads();
    hr = 0.f; hi = 0.f;
    for (int v = 0; v < w; ++v) { const float er = Cl[v * 128 + lane], ei = Cl[v * 128 + 64 + lane]; const float nr = pr * hr - pi * hi + er, ni = pr * hi + pi * hr + ei; hr = nr; hi = ni; }
    for (int tile = 0; tile < 32; ++tile) {
        const s16x4 uf = *(const s16x4*)(U + (rowbase + tile * 16 + fr) * 768 + 16 * g + 4 * fq);
#pragma unroll
        for (int nb = 0; nb < 4; ++nb) {
            const f32x4 z = (f32x4){0.f, 0.f, 0.f, 0.f};
            const f32x4 wre = __builtin_amdgcn_mfma_f32_16x16x16bf16_1k(abr[nb], uf, z, 0, 0, 0);
            const f32x4 wim = __builtin_amdgcn_mfma_f32_16x16x16bf16_1k(abi[nb], uf, z, 0, 0, 0);
            *(LAS f32x4*)(Wl + fr * 132 + 16 * nb + 4 * fq) = wre; *(LAS f32x4*)(Wl + fr * 132 + 64 + 16 * nb + 4 * fq) = wim;
        }
        LDS_WAIT();
#pragma unroll
        for (int t = 0; t < 16; ++t) { const float wr_ = Wl[t * 132 + lane], wi_ = Wl[t * 132 + 64 + lane];
            const float nr = lr * hr - li * hi + wr_, ni = lr * hi + li * hr + wi_; hr = nr; hi = ni;
            Hl[t * 136 + lane] = (bf16)(pk2(hr, 0.f) & 0xffffu); Hl[t * 136 + 64 + lane] = (bf16)(pk2(hi, 0.f) & 0xffffu); }
        LDS_WAIT();
        f32x4 y = (f32x4){0.f, 0.f, 0.f, 0.f};
#pragma unroll
        for (int kb = 0; kb < 4; ++kb) { const bf16x8 hf = *(const LAS bf16x8*)(Hl + fr * 136 + 32 * kb + 8 * fq); y = __builtin_amdgcn_mfma_f32_16x16x32_bf16(cf[kb], hf, y, 0, 0, 0); }
        f32x4 o;
#pragma unroll
        for (int j = 0; j < 4; ++j) o[j] = gelu_tanh(y[j] + dv[j] * bf2f((unsigned short)uf[j]));
        u32x2 pk; pk.x = pk2(o[0], o[1]); pk.y = pk2(o[2], o[3]);
        *(u32x2*)(YS + (rowbase + tile * 16 + fr) * 768 + 16 * g + 4 * fq) = pk;
        LDS_WAIT();
    }
    __syncthreads();
}

__device__ __forceinline__ void attn_unit(const Args& A, int gi, int b, int hh, int blk, LAS unsigned char* lds) {
    const int tid = threadIdx.x, lane = tid & 63, w = __builtin_amdgcn_readfirstlane(tid >> 6), fr = lane & 15, fq = lane >> 4;
    const int d = (gi == 0) ? 1 : (gi == 1 ? 4 : 16);
    const int r = blk % d, n = blk / d;
    const int hc = (gi * 4 + hh) * 64;
    const bf16* Q = (const bf16*)(A.ws + WS_Q); const bf16* K = (const bf16*)(A.ws + WS_K); const bf16* V = (const bf16*)(A.ws + WS_V);
    bf16* OG = (bf16*)(A.ws + (gi == 0 ? WS_OG0 : (gi == 1 ? WS_OG1 : WS_OG2)));
    float* LSE = (float*)(A.ws + WS_LSE) + (size_t)gi * M * 4;
    LAS unsigned char* Kl = lds;
    LAS unsigned char* Vl = lds + 256 * 144;
#pragma unroll
    for (int j = 0; j < 4; ++j) {
        const int p = tid + 512 * j, key = p >> 3, ch = p & 7;
        const int mi = (n - 1) * 128 + key;
        u32x4 kv = (u32x4){0u, 0u, 0u, 0u}, vv = kv;
        if (mi >= 0) { const size_t row = (size_t)b * SEQ + (size_t)mi * d + r; kv = *(const u32x4*)(K + row * 768 + hc + ch * 8); vv = *(const u32x4*)(V + row * 768 + hc + ch * 8); }
        *(LAS u32x4*)(Kl + key * 144 + ch * 16) = kv;
        LAS bf16* vt = (LAS bf16*)(Vl + (ch * 8) * 528 + key * 2);
        vt[0 * 264] = (bf16)(vv.x & 0xffffu); vt[1 * 264] = (bf16)(vv.x >> 16); vt[2 * 264] = (bf16)(vv.y & 0xffffu); vt[3 * 264] = (bf16)(vv.y >> 16);
        vt[4 * 264] = (bf16)(vv.z & 0xffffu); vt[5 * 264] = (bf16)(vv.z >> 16); vt[6 * 264] = (bf16)(vv.w & 0xffffu); vt[7 * 264] = (bf16)(vv.w >> 16);
    }
    const int qi = 16 * w + fr;
    const size_t qrow = (size_t)b * SEQ + (size_t)(n * 128 + qi) * d + r;
    const bf16x8 q0 = *(const bf16x8*)(Q + qrow * 768 + hc + 8 * fq), q1 = *(const bf16x8*)(Q + qrow * 768 + hc + 32 + 8 * fq);
    __syncthreads();
    f32x4 s[9];
    const float SC = 0.125f * LOG2E;
    float mx = -3.0e38f;
#pragma unroll
    for (int t = 0; t < 9; ++t) {
        const int kt = w + t;
        const bf16x8 k0 = *(const LAS bf16x8*)(Kl + (kt * 16 + fr) * 144 + fq * 16), k1 = *(const LAS bf16x8*)(Kl + (kt * 16 + fr) * 144 + 64 + fq * 16);
        f32x4 a = (f32x4){0.f, 0.f, 0.f, 0.f};
        a = __builtin_amdgcn_mfma_f32_16x16x32_bf16(k0, q0, a, 0, 0, 0);
        a = __builtin_amdgcn_mfma_f32_16x16x32_bf16(k1, q1, a, 0, 0, 0);
#pragma unroll
        for (int j = 0; j < 4; ++j) { const int ki = kt * 16 + 4 * fq + j; const bool ok = (ki >= qi) && (ki <= qi + 128) && (n > 0 || ki >= 128);
            a[j] = ok ? a[j] * SC : -3.0e38f; mx = fmaxf(mx, a[j]); }
        s[t] = a;
    }
    mx = fmaxf(mx, __shfl_xor(mx, 16)); mx = fmaxf(mx, __shfl_xor(mx, 32));
    float den = 0.f;
#pragma unroll
    for (int t = 0; t < 9; ++t)
#pragma unroll
        for (int j = 0; j < 4; ++j) { const float p = __builtin_amdgcn_exp2f(s[t][j] - mx); s[t][j] = p; den += p; }
    den += __shfl_xor(den, 16); den += __shfl_xor(den, 32);
    f32x4 o[4];
#pragma unroll
    for (int db = 0; db < 4; ++db) o[db] = (f32x4){0.f, 0.f, 0.f, 0.f};
#pragma unroll
    for (int c = 0; c < 5; ++c) {
        const int t0 = 2 * c, t1 = 2 * c + 1;
        u32x4 pw; pw.x = pk2(s[t0][0], s[t0][1]); pw.y = pk2(s[t0][2], s[t0][3]);
        if (t1 < 9) { pw.z = pk2(s[t1 < 9 ? t1 : 0][0], s[t1 < 9 ? t1 : 0][1]); pw.w = pk2(s[t1 < 9 ? t1 : 0][2], s[t1 < 9 ? t1 : 0][3]); } else { pw.z = 0u; pw.w = 0u; }
        const bf16x8 pf = __builtin_bit_cast(bf16x8, pw);
#pragma unroll
        for (int db = 0; db < 4; ++db) {
            u32x4 vw;
            const u32x2 lo = *(const LAS u32x2*)(Vl + (db * 16 + fr) * 528 + ((w + t0) * 16 + 4 * fq) * 2);
            vw.x = lo.x; vw.y = lo.y;
            if (t1 < 9) { const u32x2 hi2 = *(const LAS u32x2*)(Vl + (db * 16 + fr) * 528 + ((w + t1) * 16 + 4 * fq) * 2); vw.z = hi2.x; vw.w = hi2.y; } else { vw.z = 0u; vw.w = 0u; }
            o[db] = __builtin_amdgcn_mfma_f32_16x16x32_bf16(__builtin_bit_cast(bf16x8, vw), pf, o[db], 0, 0, 0);
        }
    }
    const float inv = 1.0f / den;
#pragma unroll
    for (int db = 0; db < 4; ++db) { u32x2 pk; pk.x = pk2(o[db][0] * inv, o[db][1] * inv); pk.y = pk2(o[db][2] * inv, o[db][3] * inv);
        *(u32x2*)(OG + qrow * 256 + hh * 64 + db * 16 + 4 * fq) = pk; }
    if (fq == 0) LSE[qrow * 4 + hh] = (mx + __builtin_amdgcn_logf(den)) * LN2;
    __syncthreads();
}

__device__ __forceinline__ void xattn_unit(const Args& A, int b, int xh, int qb, LAS unsigned char* lds) {
    const int tid = threadIdx.x, lane = tid & 63, w = __builtin_amdgcn_readfirstlane(tid >> 6), fr = lane & 15, fq = lane >> 4;
    const bf16* QX = (const bf16*)(A.ws + WS_QX); const bf16* KX = (const bf16*)(A.ws + WS_KX) + (size_t)(b * 4 + xh) * 65536; const bf16* VXT = (const bf16*)(A.ws + WS_VXT) + (size_t)(b * 4 + xh) * 65536;
    bf16* XO = (bf16*)(A.ws + WS_XO);
#pragma unroll 4
    for (int j = 0; j < 16; ++j) { const int p = tid + 512 * j, rw = p >> 5, ch = p & 31; *(LAS u32x4*)(lds + rw * 528 + ch * 16) = *(const u32x4*)(KX + (size_t)rw * 256 + ch * 8); }
    const size_t qrow = (size_t)b * SEQ + qb * 128 + 16 * w + fr;
    bf16x8 qf[8];
#pragma unroll
    for (int ks = 0; ks < 8; ++ks) qf[ks] = *(const bf16x8*)(QX + qrow * 1024 + xh * 256 + ks * 32 + 8 * fq);
    __syncthreads();
    f32x4 s[16];
    const float SC = 0.0625f * LOG2E;
    float mx = -3.0e38f;
#pragma unroll
    for (int kt = 0; kt < 16; ++kt) {
        f32x4 a = (f32x4){0.f, 0.f, 0.f, 0.f};
#pragma unroll
        for (int ks = 0; ks < 8; ++ks) { const bf16x8 kf = *(const LAS bf16x8*)(lds + (kt * 16 + fr) * 528 + ks * 64 + fq * 16); a = __builtin_amdgcn_mfma_f32_16x16x32_bf16(kf, qf[ks], a, 0, 0, 0); }
#pragma unroll
        for (int j = 0; j < 4; ++j) { a[j] *= SC; mx = fmaxf(mx, a[j]); }
        s[kt] = a;
    }
    mx = fmaxf(mx, __shfl_xor(mx, 16)); mx = fmaxf(mx, __shfl_xor(mx, 32));
    float den = 0.f;
    bf16x8 pf[8];
#pragma unroll
    for (int c = 0; c < 8; ++c) {
        f32x4 p0, p1;
#pragma unroll
        for (int j = 0; j < 4; ++j) { p0[j] = __builtin_amdgcn_exp2f(s[2 * c][j] - mx); p1[j] = __builtin_amdgcn_exp2f(s[2 * c + 1][j] - mx); den += p0[j] + p1[j]; }
        pf[c] = __builtin_bit_cast(bf16x8, pg8::pack8(p0, p1));
    }
    den += __shfl_xor(den, 16); den += __shfl_xor(den, 32);
    __syncthreads();
#pragma unroll 4
    for (int j = 0; j < 16; ++j) { const int p = tid + 512 * j, rw = p >> 5, ch = p & 31; *(LAS u32x4*)(lds + rw * 528 + ch * 16) = *(const u32x4*)(VXT + (size_t)rw * 256 + ch * 8); }
    __syncthreads();
    const float inv = 1.0f / den;
#pragma unroll
    for (int db = 0; db < 16; ++db) {
        f32x4 o = (f32x4){0.f, 0.f, 0.f, 0.f};
#pragma unroll
        for (int c = 0; c < 8; ++c) {
            const u32x2 lo = *(const LAS u32x2*)(lds + (db * 16 + fr) * 528 + (c * 32 + 4 * fq) * 2), hi2 = *(const LAS u32x2*)(lds + (db * 16 + fr) * 528 + (c * 32 + 16 + 4 * fq) * 2);
            u32x4 vw; vw.x = lo.x; vw.y = lo.y; vw.z = hi2.x; vw.w = hi2.y;
            o = __builtin_amdgcn_mfma_f32_16x16x32_bf16(__builtin_bit_cast(bf16x8, vw), pf[c], o, 0, 0, 0);
        }
        u32x2 pk; pk.x = pk2(o[0] * inv, o[1] * inv); pk.y = pk2(o[2] * inv, o[3] * inv);
        *(u32x2*)(XO + qrow * 1024 + xh * 256 + db * 16 + 4 * fq) = pk;
    }
    __syncthreads();
}

__global__ void __launch_bounds__(NT, 2) fwd_megakernel(Args A) {
    extern __shared__ __attribute__((aligned(16))) unsigned char lds_raw[];
    LAS unsigned char* lds = (LAS unsigned char*)lds_raw;
    cg::grid_group grid = cg::this_grid();
    const int tid = threadIdx.x, lane = tid & 63, wave = __builtin_amdgcn_readfirstlane(tid >> 6);
    const int G = gridDim.x, bx = blockIdx.x;
    const int gw = bx * NW + wave, NGW = G * NW;
    unsigned char* ws = A.ws;
    unsigned* ctl = (unsigned*)(ws + WS_CTL);
    LAS int* slot = (LAS int*)(lds + LDS_BYTES - 16);
    volatile LAS unsigned* bst = (volatile LAS unsigned*)(lds + LDS_BYTES - 32);
    if (tid < 2) bst[tid] = 0u;
    __syncthreads();
    const XcdBarrier bar = xcd_barrier_post(ctl + BAR_WORD0, bst);
    const float* x = (const float*)A.in[0];
    float* out = A.out;

    {
        LAS float* scr = (LAS float*)(lds + wave * 16384);
        constexpr int I0 = 16 * 160, I1 = 12 * 64, I2 = 4 * 32, I3 = 16 * 32, I4 = 16 * 32, I5 = 16 * 64, I6 = 16 * 32, I7 = 16 * 128, I8 = 64 * 32;
        constexpr int NITEMS = I0 + I1 + I2 + I3 + I4 + I5 + I6 + I7 + I8;
        for (int it = gw; it < NITEMS; it += NGW) {
            int r = it;
            if (r < I0) { p0_matrix((const float*)A.in[5], 1024, 5120, (bf16*)(ws + WS_W_IN), false, scr, lane, r); continue; } r -= I0;
            if (r < I1) { p0_matrix((const float*)A.in[15], 768, 2048, (bf16*)(ws + WS_W_GLU), true, scr, lane, r); continue; } r -= I1;
            if (r < I2) { p0_matrix((const float*)A.in[17], 256, 1024, (bf16*)(ws + WS_W_UP), false, scr, lane, r); continue; } r -= I2;
            if (r < I3) { p0_matrix((const float*)A.in[18], 1024, 1024, (bf16*)(ws + WS_W_MIX), false, scr, lane, r); continue; } r -= I3;
            if (r < I4) { p0_matrix((const float*)A.in[22], 1024, 1024, (bf16*)(ws + WS_W_XQ), false, scr, lane, r); continue; } r -= I4;
            if (r < I5) { p0_matrix((const float*)A.in[23], 1024, 2048, (bf16*)(ws + WS_W_XKV), false, scr, lane, r); continue; } r -= I5;
            if (r < I6) { p0_matrix((const float*)A.in[24], 1024, 1024, (bf16*)(ws + WS_W_XO), false, scr, lane, r); continue; } r -= I6;
            if (r < I7) { p0_matrix((const float*)A.in[27], 1024, 4096, (bf16*)(ws + WS_W_FF1), false, scr, lane, r); continue; } r -= I7;
            p0_matrix((const float*)A.in[29], 4096, 1024, (bf16*)(ws + WS_W_FF2), false, scr, lane, r);
        }
        for (int m = gw; m < M; m += NGW) ln_row(x + (size_t)m * D, (const float*)A.in[3], (const float*)A.in[4], out + (size_t)m * D, (bf16*)(ws + WS_H0B) + (size_t)m * D, lane);
        { const float* mem = (const float*)A.in[1]; bf16* mb = (bf16*)(ws + WS_MEMB);
          for (int i = bx * NT + tid; i < 1024 * 1024 / 8; i += G * NT) { const f32x4 a = ((const f32x4*)mem)[2 * i], c = ((const f32x4*)mem)[2 * i + 1]; ((u32x4*)mb)[i] = pg8::pack8(a, c); } }
        { const int* pos = (const int*)A.in[2]; float* rope = (float*)(ws + WS_ROPE);
          for (int i = bx * NT + tid; i < M * 8; i += G * NT) { const int row = i >> 3, k = i & 7;
              const float invf = (k == 0) ? 1.0f : (k == 1) ? 0.19392274f : (k == 2) ? 0.03760603f : (k == 3) ? 0.0072926646f : (k == 4) ? 0.0014142136f : (k == 5) ? 0.0002742482f : (k == 6) ? 5.3182957e-05f : 1.0313385e-05f;
              const float ang = (float)pos[row] * invf; rope[row * 16 + k] = cosf(ang); rope[row * 16 + 8 + k] = sinf(ang); } }
    }
    grid.sync();

    {
        pg8::Gemm g{(const pg8::bf16_t*)(ws + WS_H0B), (const pg8::bf16_t*)(ws + WS_W_IN), M, INC, D}; pg8::StaticOrder S; S.init(M, INC, G, bx);
        pg8::EpiProj E{(bf16*)(ws + WS_U), (bf16*)(ws + WS_Q), (bf16*)(ws + WS_K), (bf16*)(ws + WS_V), (bf16*)(ws + WS_GS), (bf16*)(ws + WS_GA), (const float*)A.in[6], (const float*)(ws + WS_ROPE)};
        pg8::gemm_phase<pg8::EpiProj, pg8::StaticOrder, true, true>(lds, g, S, E);
    }
    {
        pg8::Gemm g{(const pg8::bf16_t*)(ws + WS_MEMB), (const pg8::bf16_t*)(ws + WS_W_XKV), 1024, 2048, D}; pg8::StaticOrder S; S.init(1024, 2048, G, (bx + 128) % G);
        pg8::EpiXkv E{(bf16*)(ws + WS_KX), (bf16*)(ws + WS_VXT)};
        pg8::gemm_phase<pg8::EpiXkv, pg8::StaticOrder, true, true>(lds, g, S, E);
    }
    xcd_barrier(bar);

    for (;;) {
        __syncthreads(); if (tid == 0) *slot = (int)atomicAdd(ctl + 0, 1u); __syncthreads();
        const int u = *slot;
        if (u >= 192 + 1536) break;
        if (u < 192) ssm_unit(A, u / 48, u % 48, lds);
        else { const int a = u - 192; attn_unit(A, a / 512, (a % 512) / 128, (a / 32) % 4, a % 32, lds); }
    }
    xcd_barrier(bar);

    {
        const bf16* og0 = (const bf16*)(ws + WS_OG0); const bf16* og1 = (const bf16*)(ws + WS_OG1); const bf16* og2 = (const bf16*)(ws + WS_OG2);
        const float* lse = (const float*)(ws + WS_LSE); bf16* att = (bf16*)(ws + WS_ATT);
        for (int i = bx * NT + tid; i < M * 32; i += G * NT) {
            const int rh = i >> 3;
            const float l0 = lse[rh], l1 = lse[(size_t)M * 4 + rh], l2 = lse[(size_t)M * 8 + rh];
            const float mm = fmaxf(l0, fmaxf(l1, l2)); float w0 = __expf(l0 - mm), w1 = __expf(l1 - mm), w2 = __expf(l2 - mm); const float iz = 1.0f / (w0 + w1 + w2); w0 *= iz; w1 *= iz; w2 *= iz;
            f32x4 a0, a1, b0, b1, c0, c1; pg8::unpack8(((const u32x4*)og0)[i], a0, a1); pg8::unpack8(((const u32x4*)og1)[i], b0, b1); pg8::unpack8(((const u32x4*)og2)[i], c0, c1);
            ((u32x4*)att)[i] = pg8::pack8(a0 * w0 + b0 * w1 + c0 * w2, a1 * w0 + b1 * w1 + c1 * w2);
        }
        pg8::Gemm g{(const pg8::bf16_t*)(ws + WS_YS), (const pg8::bf16_t*)(ws + WS_W_GLU), M, 2048, 768}; pg8::StaticOrder S; S.init(M, 2048, G, bx);
        pg8::EpiGlu E{(bf16*)(ws + WS_MIX), (const bf16*)(ws + WS_GS), (const float*)A.in[16]};
        pg8::gemm_phase<pg8::EpiGlu, pg8::StaticOrder, true, true>(lds, g, S, E);
    }
    xcd_barrier(bar);

    {
        int kup = 256; asm volatile("" : "+s"(kup));
        pg8::Gemm g{(const pg8::bf16_t*)(ws + WS_ATT), (const pg8::bf16_t*)(ws + WS_W_UP), M, D, kup}; pg8::StaticOrder S; S.init(M, D, G, bx);
        pg8::EpiUp E{(bf16*)(ws + WS_MIX), (const bf16*)(ws + WS_GA)};
        pg8::gemm_phase<pg8::EpiUp, pg8::StaticOrder, true, true>(lds, g, S, E);
    }
    xcd_barrier(bar);

    {
        pg8::Gemm g{(const pg8::bf16_t*)(ws + WS_MIX), (const pg8::bf16_t*)(ws + WS_W_MIX), M, D, D}; pg8::StaticOrder S; S.init(M, D, G, bx);
        pg8::EpiRes E{out, (const float*)A.in[19], ALPHA};
        pg8::gemm_phase<pg8::EpiRes, pg8::StaticOrder, true, true>(lds, g, S, E);
    }
    xcd_barrier(bar);
    for (int m = gw; m < M; m += NGW) ln_row(out + (size_t)m * D, (const float*)A.in[20], (const float*)A.in[21], out + (size_t)m * D, (bf16*)(ws + WS_H1B) + (size_t)m * D, lane);
    xcd_barrier(bar);

    {
        pg8::Gemm g{(const pg8::bf16_t*)(ws + WS_H1B), (const pg8::bf16_t*)(ws + WS_W_XQ), M, D, D}; pg8::StaticOrder S; S.init(M, D, G, bx);
        pg8::EpiPlain<0> E{(bf16*)(ws + WS_QX), D, nullptr, 1.0f};
        pg8::gemm_phase<pg8::EpiPlain<0>, pg8::StaticOrder, true, true>(lds, g, S, E);
    }
    xcd_barrier(bar);

    for (int u = bx; u < 512; u += G) xattn_unit(A, u / 128, (u / 32) % 4, u % 32, lds);
    xcd_barrier(bar);

    {
        pg8::Gemm g{(const pg8::bf16_t*)(ws + WS_XO), (const pg8::bf16_t*)(ws + WS_W_XO), M, D, D}; pg8::StaticOrder S; S.init(M, D, G, bx);
        pg8::EpiRes E{out, nullptr, ALPHA};
        pg8::gemm_phase<pg8::EpiRes, pg8::StaticOrder, true, true>(lds, g, S, E);
    }
    xcd_barrier(bar);
    for (int m = gw; m < M; m += NGW) ln_row(out + (size_t)m * D, (const float*)A.in[25], (const float*)A.in[26], out + (size_t)m * D, (bf16*)(ws + WS_H2B) + (size_t)m * D, lane);
    xcd_barrier(bar);

    {
        pg8::Gemm g{(const pg8::bf16_t*)(ws + WS_H2B), (const pg8::bf16_t*)(ws + WS_W_FF1), M, FF, D}; pg8::StaticOrder S; S.init(M, FF, G, bx);
        pg8::EpiPlain<2> E{(bf16*)(ws + WS_FFH), FF, (const float*)A.in[28], 1.0f};
        pg8::gemm_phase<pg8::EpiPlain<2>, pg8::StaticOrder, true, true>(lds, g, S, E);
    }
    xcd_barrier(bar);

    {
        pg8::Gemm g{(const pg8::bf16_t*)(ws + WS_FFH), (const pg8::bf16_t*)(ws + WS_W_FF2), M, D, FF}; pg8::StaticOrder S; S.init(M, D, G, bx);
        pg8::EpiRes E{out, (const float*)A.in[30], ALPHA};
        pg8::gemm_phase<pg8::EpiRes, pg8::StaticOrder, true, true>(lds, g, S, E);
    }
    xcd_barrier(bar);
    for (int m = gw; m < M; m += NGW) ln_row(out + (size_t)m * D, (const float*)A.in[31], (const float*)A.in[32], out + (size_t)m * D, nullptr, lane);
}

extern "C" void kernel_launch(void* const* d_in, const int* in_sizes, int n_in, void* d_out, int out_size, void* d_ws, size_t ws_size, hipStream_t stream) {
    static int grid = 0;
    if (grid == 0) {
        int dev = 0, cus = 0, per_cu = 0;
        hipGetDevice(&dev);
        hipDeviceGetAttribute(&cus, hipDeviceAttributeMultiprocessorCount, dev);
        hipFuncSetAttribute((const void*)fwd_megakernel, hipFuncAttributeMaxDynamicSharedMemorySize, LDS_BYTES);
        hipOccupancyMaxActiveBlocksPerMultiprocessor(&per_cu, (const void*)fwd_megakernel, NT, LDS_BYTES);
        if (per_cu < 1) per_cu = 1;
        grid = cus * 1;
        (void)hipGetLastError();
        if (n_in != 33 || ws_size < 256 * MiB) { fprintf(stderr, "kernel_launch: unexpected n_in %d / ws %zu\n", n_in, ws_size); }
    }
    hipMemsetAsync((char*)d_ws + WS_CTL, 0, CTL_ZERO, stream);
    Args a{};
    for (int i = 0; i < 33; ++i) a.in[i] = d_in[i];
    a.out = (float*)d_out; a.ws = (unsigned char*)d_ws;
    void* args[] = {&a};
    hipError_t e = hipLaunchCooperativeKernel((const void*)fwd_megakernel, dim3(grid), dim3(NT), args, LDS_BYTES, stream);
    if (e != hipSuccess) fprintf(stderr, "cooperative launch failed: %s (grid %d)\n", hipGetErrorString(e), grid);
}
```
